# Optimizing an MI355X kernel written in HIP

```python
import math
import jax
import jax.numpy as jnp
from jax import lax
import numpy as np

D_MODEL = 1024
BATCH = 8
SEQ = 4096
DEPTH = 2

GRID_W = 64
CTX_LEN = 256
NORM_EPS = 1e-6

HYENA_W = 512
HYENA_ORDER = 2
SHORT_CONV = 3
N_BANDS = 16
POS_EMB_DIM = 1 + 2 * N_BANDS
FILTER_HIDDEN = 64
HYENA_TARGET = 1e-2
HYENA_FAST_DECAY = 0.3
HYENA_SLOW_DECAY = 1.5
HYENA_MAX_DECAY = math.log(HYENA_TARGET) / HYENA_FAST_DECAY
HYENA_MIN_DECAY = math.log(HYENA_TARGET) / HYENA_SLOW_DECAY

MLA_HEADS = 16
QK_NOPE = 64
QK_ROPE = 32
V_HEAD = 64
Q_LORA = 384
KV_LORA = 256
ROPE_BASE = 10000.0
AXIS_ROPE = QK_ROPE // 2
ATTN_SCALE = (QK_NOPE + QK_ROPE) ** -0.5
Q_BLOCK = 128

D_FF = -(-8 * D_MODEL // (3 * 256)) * 256

HY_COLS = (HYENA_ORDER + 1) * HYENA_W
OFF_Q = HY_COLS
OFF_KV = OFF_Q + Q_LORA
OFF_G = OFF_KV + KV_LORA + QK_ROPE
IN_COLS = OFF_G + 2 * D_MODEL

kernel_name = "hybrid_hyena_mla_dit_block"


def rmsnorm(x, g):
    xf = x.astype(jnp.float32)
    y = xf * lax.rsqrt(jnp.mean(xf * xf, axis=-1, keepdims=True) + NORM_EPS)
    return (y * g.astype(jnp.float32)).astype(x.dtype)


def modulate(h, shift, scale):
    return h * (1 + scale) + shift


def axial_rope_tables(n_tokens):
    rows = n_tokens // GRID_W
    row = jnp.repeat(jnp.arange(rows, dtype=jnp.float32), GRID_W)
    col = jnp.tile(jnp.arange(GRID_W, dtype=jnp.float32), rows)
    inv = ROPE_BASE ** (-jnp.arange(0, AXIS_ROPE, 2, dtype=jnp.float32) / AXIS_ROPE)
    ang = jnp.concatenate([row[:, None] * inv, col[:, None] * inv], axis=-1)
    return jnp.cos(ang), jnp.sin(ang)


def apply_rope(x, cos, sin):
    half = QK_ROPE // 2
    x1, x2 = x[..., :half], x[..., half:]
    return jnp.concatenate([x1 * cos - x2 * sin, x1 * sin + x2 * cos], axis=-1).astype(x.dtype)


def short_conv(u, w, b):
    L = u.shape[1]
    pad = SHORT_CONV // 2
    up = jnp.pad(u, ((0, 0), (pad, pad), (0, 0)))
    return sum(up[:, j:j + L] * w[j] for j in range(SHORT_CONV)) + b


def hyena_filter_spectrum(L, w1, b1, w2, b2, w3, freq):
    f32 = jnp.float32
    t = jnp.linspace(0.0, 1.0, L, dtype=f32)[:, None]
    bands = jnp.arange(1, N_BANDS + 1, dtype=f32)
    z = jnp.concatenate([t, jnp.cos(2 * math.pi * bands * t), jnp.sin(2 * math.pi * bands * t)], axis=-1)
    h = jnp.sin(freq[0].astype(f32) * (z @ w1.astype(f32) + b1.astype(f32)))
    h = jnp.sin(freq[1].astype(f32) * (h @ w2.astype(f32) + b2.astype(f32)))
    h = (h @ w3.astype(f32)).reshape(L, 2, HYENA_ORDER, HYENA_W)
    deltas = jnp.linspace(HYENA_MIN_DECAY, HYENA_MAX_DECAY, HYENA_W, dtype=f32)
    h = h * jnp.exp(-t * jnp.abs(deltas))[:, None, None, :]
    fwd, bwd = h[:, 0], h[:, 1]
    full = jnp.concatenate([fwd, jnp.zeros_like(fwd[:1]), bwd[:0:-1]], axis=0)
    full = full / jnp.sum(jnp.abs(full), axis=0, keepdims=True)
    return jnp.fft.rfft(full, axis=0)


def long_conv(v, hf):
    L = v.shape[1]
    vf = jnp.fft.rfft(v.astype(jnp.float32), n=2 * L, axis=1)
    y = jnp.fft.irfft(vf * hf[None], n=2 * L, axis=1)[:, :L]
    return y.astype(v.dtype)


def hyena(u, conv_w, conv_b, w1, b1, w2, b2, w3, freq, bias):
    L = u.shape[1]
    u = short_conv(u, conv_w, conv_b)
    parts = jnp.split(u, HYENA_ORDER + 1, axis=-1)
    gates, v = parts[:HYENA_ORDER], parts[HYENA_ORDER]
    hf = hyena_filter_spectrum(L, w1, b1, w2, b2, w3, freq)
    for o in range(HYENA_ORDER):
        v = gates[o] * (long_conv(v, hf[:, o]) + bias[o] * v)
    return v


def mla_queries(cq, q_g, w_uq, cos, sin):
    B, L = cq.shape[:2]
    q = (rmsnorm(cq, q_g) @ w_uq).reshape(B, L, MLA_HEADS, QK_NOPE + QK_ROPE)
    q_nope, q_rope = q[..., :QK_NOPE], q[..., QK_NOPE:]
    if cos is not None:
        q_rope = apply_rope(q_rope, cos[:, None, :], sin[:, None, :])
    return q_nope, q_rope


def mla_keys(ckv_kr, kv_g, w_ukv, cos, sin):
    B, L = ckv_kr.shape[:2]
    ckv, k_rope = ckv_kr[..., :KV_LORA], ckv_kr[..., KV_LORA:]
    kv = (rmsnorm(ckv, kv_g) @ w_ukv).reshape(B, L, MLA_HEADS, QK_NOPE + V_HEAD)
    k_nope, v = kv[..., :QK_NOPE], kv[..., QK_NOPE:]
    if cos is not None:
        k_rope = apply_rope(k_rope, cos, sin)
    return k_nope, k_rope, v


def attend(q_nope, q_rope, k_nope, k_rope, v):
    s = jnp.einsum('bqhd,bkhd->bhqk', q_nope, k_nope) + jnp.einsum('bqhr,bkr->bhqk', q_rope, k_rope)
    p = jax.nn.softmax(s.astype(jnp.float32) * ATTN_SCALE, axis=-1).astype(v.dtype)
    return jnp.einsum('bhqk,bkhd->bqhd', p, v)


def attend_blocked(q_nope, q_rope, k_nope, k_rope, v):
    B, L = q_nope.shape[:2]
    nb = L // Q_BLOCK
    to_blocks = lambda t: jnp.moveaxis(t.reshape(B, nb, Q_BLOCK, *t.shape[2:]), 1, 0)
    out = lax.map(lambda qs: attend(qs[0], qs[1], k_nope, k_rope, v), (to_blocks(q_nope), to_blocks(q_rope)))
    return jnp.moveaxis(out, 0, 1).reshape(B, L, MLA_HEADS * V_HEAD)


def merge(gate_pre, gate_b, y_hy, y_att, hy_proj, mla_proj, w_out):
    g_hy, g_att = jnp.split(jax.nn.sigmoid(gate_pre + gate_b), 2, axis=-1)
    return (g_hy * (y_hy @ hy_proj) + g_att * (y_att @ mla_proj)) @ w_out


def swiglu(h, w_in, w_out):
    g, u = jnp.split(h @ w_in, 2, axis=-1)
    return (jax.nn.silu(g) * u) @ w_out


def setup_inputs(seed: int = 0) -> dict:
    key = jax.random.key(seed)
    keys = iter(jax.random.split(key, 40))

    def normal(shape, scale):
        return scale * jax.random.normal(next(keys), shape, jnp.float32)

    L = DEPTH
    return {
        "x": normal((BATCH, SEQ, D_MODEL), 1.0),
        "c": normal((BATCH, D_MODEL), 1.0),
        "ctx": normal((BATCH, CTX_LEN, D_MODEL), 1.0),
        "c_ctx": normal((D_MODEL,), 1.0),
        "ada_w": normal((L, D_MODEL, 6 * D_MODEL), 0.3 * D_MODEL ** -0.5),
        "ada_b": normal((L, 6 * D_MODEL), 0.02),
        "norm1_g": 1.0 + normal((L, D_MODEL), 0.05),
        "norm2_g": 1.0 + normal((L, D_MODEL), 0.05),
        "w_in": normal((L, D_MODEL, IN_COLS), D_MODEL ** -0.5),
        "gate_b": normal((L, 2 * D_MODEL), 0.02),
        "hy_conv_w": normal((L, SHORT_CONV, HY_COLS), SHORT_CONV ** -0.5),
        "hy_conv_b": normal((L, HY_COLS), 0.02),
        "hy_filt_w1": normal((L, POS_EMB_DIM, FILTER_HIDDEN), POS_EMB_DIM ** -0.5),
        "hy_filt_b1": normal((L, FILTER_HIDDEN), 0.02),
        "hy_filt_w2": normal((L, FILTER_HIDDEN, FILTER_HIDDEN), FILTER_HIDDEN ** -0.5),
        "hy_filt_b2": normal((L, FILTER_HIDDEN), 0.02),
        "hy_filt_w3": normal((L, FILTER_HIDDEN, 2 * HYENA_ORDER * HYENA_W), FILTER_HIDDEN ** -0.5),
        "hy_filt_freq": 1.0 + normal((L, 2, FILTER_HIDDEN), 0.1),
        "hy_bias": normal((L, HYENA_ORDER, HYENA_W), 0.5),
        "hy_proj": normal((L, HYENA_W, D_MODEL), HYENA_W ** -0.5),
        "q_norm_g": 1.0 + normal((L, Q_LORA), 0.05),
        "kv_norm_g": 1.0 + normal((L, KV_LORA), 0.05),
        "w_uq": normal((L, Q_LORA, MLA_HEADS * (QK_NOPE + QK_ROPE)), Q_LORA ** -0.5),
        "w_ukv": normal((L, KV_LORA, MLA_HEADS * (QK_NOPE + V_HEAD)), KV_LORA ** -0.5),
        "mla_proj": normal((L, MLA_HEADS * V_HEAD, D_MODEL), (MLA_HEADS * V_HEAD) ** -0.5),
        "w_out": normal((L, D_MODEL, D_MODEL), D_MODEL ** -0.5),
        "ffn_w_in": normal((L, D_MODEL, 2 * D_FF), D_MODEL ** -0.5),
        "ffn_w_out": normal((L, D_FF, D_MODEL), D_FF ** -0.5),
        "final_norm_g": 1.0 + normal((D_MODEL,), 0.05),
    }


def reference(x, c, ctx, c_ctx, ada_w, ada_b, norm1_g, norm2_g, w_in, gate_b,
              hy_conv_w, hy_conv_b, hy_filt_w1, hy_filt_b1, hy_filt_w2, hy_filt_b2,
              hy_filt_w3, hy_filt_freq, hy_bias, hy_proj, q_norm_g, kv_norm_g,
              w_uq, w_ukv, mla_proj, w_out, ffn_w_in, ffn_w_out, final_norm_g):
    cos_l, sin_l = axial_rope_tables(x.shape[1])
    h_lat, h_ctx = x, ctx
    for i in range(DEPTH):
        last = i == DEPTH - 1
        sh1, sc1, g1, sh2, sc2, g2 = [m[:, None, :] for m in
                                      jnp.split(jax.nn.silu(c) @ ada_w[i] + ada_b[i], 6, axis=-1)]
        csh1, csc1, cg1, csh2, csc2, cg2 = jnp.split(jax.nn.silu(c_ctx) @ ada_w[i] + ada_b[i], 6, axis=-1)
        hy_params = (hy_conv_w[i], hy_conv_b[i], hy_filt_w1[i], hy_filt_b1[i], hy_filt_w2[i],
                     hy_filt_b2[i], hy_filt_w3[i], hy_filt_freq[i], hy_bias[i])

        a_l = modulate(rmsnorm(h_lat, norm1_g[i]), sh1, sc1)
        a_c = modulate(rmsnorm(h_ctx, norm1_g[i]), csh1, csc1)
        u_l = a_l @ w_in[i]
        if last:
            u_kv_c = a_c @ w_in[i][:, OFF_KV:OFF_G]
        else:
            u_c = a_c @ w_in[i]
            u_kv_c = u_c[..., OFF_KV:OFF_G]

        kn_c, kr_c, v_c = mla_keys(u_kv_c, kv_norm_g[i], w_ukv[i], None, None)
        kn_l, kr_l, v_l = mla_keys(u_l[..., OFF_KV:OFF_G], kv_norm_g[i], w_ukv[i], cos_l, sin_l)
        qn_l, qr_l = mla_queries(u_l[..., OFF_Q:OFF_KV], q_norm_g[i], w_uq[i], cos_l, sin_l)
        kn_all = jnp.concatenate([kn_l, kn_c], axis=1)
        kr_all = jnp.concatenate([kr_l, kr_c], axis=1)
        v_all = jnp.concatenate([v_l, v_c], axis=1)
        att_l = attend_blocked(qn_l, qr_l, kn_all, kr_all, v_all)
        hy_l = hyena(u_l[..., :OFF_Q], *hy_params)
        mix_l = merge(u_l[..., OFF_G:], gate_b[i], hy_l, att_l, hy_proj[i], mla_proj[i], w_out[i])
        h_lat = h_lat + g1 * mix_l

        f_l = modulate(rmsnorm(h_lat, norm2_g[i]), sh2, sc2)
        h_lat = h_lat + g2 * swiglu(f_l, ffn_w_in[i], ffn_w_out[i])

        if not last:
            qn_c, qr_c = mla_queries(u_c[..., OFF_Q:OFF_KV], q_norm_g[i], w_uq[i], None, None)
            att_c = attend(qn_c, qr_c, kn_c, kr_c, v_c).reshape(h_ctx.shape[0], h_ctx.shape[1], MLA_HEADS * V_HEAD)
            hy_c = hyena(u_c[..., :OFF_Q], *hy_params)
            mix_c = merge(u_c[..., OFF_G:], gate_b[i], hy_c, att_c, hy_proj[i], mla_proj[i], w_out[i])
            h_ctx = h_ctx + cg1 * mix_c
            f_c = modulate(rmsnorm(h_ctx, norm2_g[i]), csh2, csc2)
            h_ctx = h_ctx + cg2 * swiglu(f_c, ffn_w_in[i], ffn_w_out[i])

    return rmsnorm(h_lat, final_norm_g)
```

```cpp
#include <hip/hip_runtime.h>
#include <hip/hip_cooperative_groups.h>
#include <cstdio>
#include <type_traits>
namespace cg = cooperative_groups;

#ifndef MULTI_LAUNCH
#define MULTI_LAUNCH 0
#endif

#define DI __device__ __forceinline__
typedef unsigned short u16;
typedef __attribute__((ext_vector_type(8))) short bf16x8;
typedef __attribute__((ext_vector_type(16))) float f32x16;
typedef __attribute__((ext_vector_type(4))) float f32x4;
typedef __attribute__((ext_vector_type(2))) float f32x2;
typedef __attribute__((ext_vector_type(4))) unsigned u32x4;
typedef __attribute__((ext_vector_type(2))) unsigned u32x2;
typedef __attribute__((ext_vector_type(2))) __bf16 bf16x2_t;
typedef __attribute__((ext_vector_type(2))) _Float16 f16x2_t;

constexpr int DM = 1024, NBATCH = 8, SEQ = 4096, CTXL = 256;
constexpr int RL = NBATCH * SEQ, RC = NBATCH * CTXL, MT = RL + RC;
constexpr int HYW = 512, QL = 384, KVL = 256, NH = 16, DFF = 2816;
constexpr int KEYS = SEQ + CTXL;
constexpr int INC = 4256, OFFG = 2208;
constexpr float EPS = 1e-6f;
constexpr int LDS_BYTES = 74752;
constexpr int NTHREADS = 256;

constexpr size_t SZ_Q = (size_t)MT * 1536 * 2, SZ_A = (size_t)MT * 1024 * 2, SZ_CQ = (size_t)MT * QL * 2,
                 SZ_CKV = (size_t)MT * KVL * 2, SZ_KR = (size_t)MT * 32 * 2, SZ_UT = (size_t)1536 * MT * 2;
constexpr size_t OFF_Q = 0, OFF_A = OFF_Q + SZ_Q, OFF_CQ = OFF_A + SZ_A, OFF_CKV = OFF_CQ + SZ_CQ, OFF_KR = OFF_CKV + SZ_CKV,
                 OFF_KN = OFF_KR + SZ_KR, OFF_VT = OFF_KN + SZ_A, OFF_UT = OFF_VT + SZ_A, OFF_WT = OFF_UT + SZ_UT;
constexpr long WIN_O = 0, WUQ_O = WIN_O + 4256L * 1024, WUKV_O = WUQ_O + 1536L * 384, WHY_O = WUKV_O + 2048L * 256,
               WMLA_O = WHY_O + 1024L * 512, WOUT_O = WMLA_O + 1024L * 1024, WFIN_O = WOUT_O + 1024L * 1024,
               WFOUT_O = WFIN_O + 5632L * 1024, WT_ELEMS = WFOUT_O + 1024L * 2816;
constexpr size_t OFF_HC = OFF_WT + (size_t)WT_ELEMS * 2, OFF_MOD = OFF_HC + (size_t)RC * 1024 * 4,
                 OFF_H2 = OFF_MOD + (size_t)2 * 9 * 6144 * 4, OFF_H2C = OFF_H2 + (size_t)2 * 4096 * 64 * 4,
                 OFF_ROPE = OFF_H2C + (size_t)256 * 64 * 4, WS_END = OFF_ROPE + (size_t)2 * 4096 * 16 * 4;
constexpr size_t OFF_G8 = OFF_Q;
constexpr size_t OFF_QN = OFF_Q + SZ_A;
static_assert(OFF_QN + SZ_Q == OFF_CQ, "q must end where cq starts");
static_assert((size_t)2048 * MT <= SZ_A, "gate8 fits below q");
constexpr size_t OFF_BAR = WS_END;
static_assert(WS_END + 256 <= 536870912ull, "workspace too large");
static_assert((size_t)MT * DFF * 2 <= SZ_A * 2 + SZ_UT, "act does not fit");

struct Params {
  const float* in[29];
  float* out;
  char* ws;
};

DI int otid() { int t = threadIdx.x; asm volatile("" : "+v"(t)); return t; }
DI unsigned pack2(float lo, float hi) { f32x2 v = {lo, hi}; bf16x2_t b = __builtin_convertvector(v, bf16x2_t); return __builtin_bit_cast(unsigned, b); }
DI u16 f2bf(float x) { return (u16)(pack2(x, 0.f) & 0xffffu); }
DI float bf2f(u16 b) { return __uint_as_float((unsigned)b << 16); }
DI int crow(int r, int hi) { return (r & 3) + 8 * (r >> 2) + 4 * hi; }
DI float sigmoidf_(float x) { return __builtin_amdgcn_rcpf(1.f + __expf(-x)); }
DI float wave_sum(float v) {
#pragma unroll
  for (int o = 32; o >= 1; o >>= 1) v += __shfl_xor(v, o);
  return v;
}
DI float dpp_swap1(float v) { return __builtin_bit_cast(float, __builtin_amdgcn_mov_dpp(__builtin_bit_cast(int, v), 0xB1, 0xF, 0xF, true)); }
DI void store_tile_bf16(u16* dst, long ld, const float (&v)[16], int r32, int hi) {
  const bool odd = r32 & 1;
#pragma unroll
  for (int rp = 0; rp < 8; ++rp) {
    const float a = v[2 * rp], b = v[2 * rp + 1];
    const float recv = dpp_swap1(odd ? a : b);
    const int row = ((2 * rp) & 3) + 8 * ((2 * rp) >> 2) + 4 * hi + (odd ? 1 : 0);
    const unsigned w = odd ? pack2(recv, b) : pack2(a, recv);
    *(unsigned*)(dst + (long)row * ld + (r32 & ~1)) = w;
  }
}
#define MFMA32(a, b, c) __builtin_amdgcn_mfma_f32_32x32x16_bf16((a), (b), (c), 0, 0, 0)

DI void wconv_item(const Params& p, int layer, int it, char* smem) {
  int K, N; const float* W; const float* g = nullptr; long woff;
  if (it < 1072) { K = 1024; N = 4256; W = p.in[8] + (long)layer * 1024 * 4256; woff = WIN_O; }
  else if ((it -= 1072) < 144) { K = 384; N = 1536; W = p.in[22] + (long)layer * 384 * 1536; g = p.in[20] + layer * 384; woff = WUQ_O; }
  else if ((it -= 144) < 128) { K = 256; N = 2048; W = p.in[23] + (long)layer * 256 * 2048; g = p.in[21] + layer * 256; woff = WUKV_O; }
  else if ((it -= 128) < 128) { K = 512; N = 1024; W = p.in[19] + (long)layer * 512 * 1024; woff = WHY_O; }
  else if ((it -= 128) < 256) { K = 1024; N = 1024; W = p.in[24] + (long)layer * 1024 * 1024; woff = WMLA_O; }
  else if ((it -= 256) < 256) { K = 1024; N = 1024; W = p.in[25] + (long)layer * 1024 * 1024; woff = WOUT_O; }
  else if ((it -= 256) < 1408) { K = 1024; N = 5632; W = p.in[26] + (long)layer * 1024 * 5632; woff = WFIN_O; }
  else { it -= 1408; K = 2816; N = 1024; W = p.in[27] + (long)layer * 2816 * 1024; woff = WFOUT_O; }
  const int nts = (N + 63) >> 6;
  const int kt = it / nts, nt = it - kt * nts;
  u16* tile = (u16*)smem;
  u16* Wt = (u16*)(p.ws + OFF_WT) + woff;
  const int tid = otid();
  {
    const int r = tid >> 4, c4 = tid & 15;
#pragma unroll
    for (int i = 0; i < 4; ++i) {
      const int kk = r + 16 * i, k = kt * 64 + kk, n = nt * 64 + c4 * 4;
      f32x4 v = {0.f, 0.f, 0.f, 0.f};
      if (n < N) v = *(const f32x4*)(W + (long)k * N + n);
      const float s = g ? g[k] : 1.f;
      tile[kk * 66 + c4 * 4 + 0] = f2bf(v[0] * s); tile[kk * 66 + c4 * 4 + 1] = f2bf(v[1] * s);
      tile[kk * 66 + c4 * 4 + 2] = f2bf(v[2] * s); tile[kk * 66 + c4 * 4 + 3] = f2bf(v[3] * s);
    }
  }
  __syncthreads();
  {
    const int n = tid >> 2, kc = tid & 3;
    if (nt * 64 + n < N) {
      unsigned w[8];
#pragma unroll
      for (int e = 0; e < 8; ++e) w[e] = (unsigned)tile[(kc * 16 + 2 * e) * 66 + n] | ((unsigned)tile[(kc * 16 + 2 * e + 1) * 66 + n] << 16);
      u32x4* dst = (u32x4*)(Wt + (long)(nt * 64 + n) * K + kt * 64 + kc * 16);
      dst[0] = (u32x4){w[0], w[1], w[2], w[3]}; dst[1] = (u32x4){w[4], w[5], w[6], w[7]};
    }
  }
  __syncthreads();
}

DI void mod_item(const Params& p, int it, char* smem) {
  const int layer = it / 96, n0 = (it % 96) * 64, tid = otid();
  float* s = (float*)smem;
  float* red = s + 9216;
  for (int idx = tid; idx < 9216; idx += 256) {
    const int r = idx >> 10, k = idx & 1023;
    const float cv = r < 8 ? p.in[1][r * 1024 + k] : p.in[3][k];
    s[idx] = cv / (1.f + expf(-cv));
  }
  __syncthreads();
  const int kq = tid >> 6, nn = tid & 63;
  float acc[9];
#pragma unroll
  for (int r = 0; r < 9; ++r) acc[r] = 0.f;
  const float* W = p.in[4] + (long)layer * 1024 * 6144 + n0 + nn;
  for (int k = kq; k < 1024; k += 4) {
    const float w = W[(long)k * 6144];
#pragma unroll
    for (int r = 0; r < 9; ++r) acc[r] += s[r * 1024 + k] * w;
  }
#pragma unroll
  for (int r = 0; r < 9; ++r) red[(kq * 9 + r) * 64 + nn] = acc[r];
  __syncthreads();
  float* mod = (float*)(p.ws + OFF_MOD);
  for (int idx = tid; idx < 576; idx += 256) {
    const int r = idx >> 6, c = idx & 63;
    float v = p.in[5][layer * 6144 + n0 + c];
#pragma unroll
    for (int q = 0; q < 4; ++q) v += red[(q * 9 + r) * 64 + c];
    mod[(layer * 9 + r) * 6144 + n0 + c] = v;
  }
  __syncthreads();
}

DI void h2_item(const Params& p, int it, char* smem) {
  int set, row4;
  if (it < 1024) { set = 0; row4 = it; } else if (it < 2048) { set = 1; row4 = it - 1024; } else { set = 2; row4 = it - 2048; }
  const int L = set < 2 ? 4096 : 256, layer = set == 1 ? 1 : 0;
  float* dst = set < 2 ? (float*)(p.ws + OFF_H2) + (long)set * 4096 * 64 : (float*)(p.ws + OFF_H2C);
  const int tid = otid(), rr = tid >> 6, c = tid & 63, row = row4 * 4 + rr;
  const float t = (float)row / (float)(L - 1);
  float* zs = (float*)smem;
  float* h1s = zs + 4 * 36;
  if (c < 33) {
    float val;
    if (c == 0) val = t; else if (c <= 16) val = cospif(2.f * (float)c * t); else val = sinpif(2.f * (float)(c - 16) * t);
    zs[rr * 36 + c] = val;
  }
  __syncthreads();
  const float* w1 = p.in[12] + layer * 33 * 64, *b1 = p.in[13] + layer * 64, *w2 = p.in[14] + layer * 64 * 64, *b2 = p.in[15] + layer * 64;
  const float* fr = p.in[17] + layer * 128;
  float a = b1[c];
  for (int i = 0; i < 33; ++i) a += zs[rr * 36 + i] * w1[i * 64 + c];
  h1s[rr * 64 + c] = sinf(fr[c] * a);
  __syncthreads();
  a = b2[c];
  for (int k = 0; k < 64; ++k) a += h1s[rr * 64 + k] * w2[k * 64 + c];
  dst[(long)row * 64 + c] = sinf(fr[64 + c] * a);
  __syncthreads();
}

DI void rope_item(const Params& p, int it) {
  const int idx = it * 256 + otid(), t = idx >> 4, i = idx & 15;
  const float pos = (float)(i < 8 ? (t >> 6) : (t & 63));
  const float inv = exp2f(-(float)(i & 7) * (13.287712379549449f / 8.f));
  float sn, cs; sincosf(pos * inv, &sn, &cs);
  float* rc = (float*)(p.ws + OFF_ROPE);
  rc[idx] = cs; rc[4096 * 16 + idx] = sn;
}

DI void norm_rows(const Params& p, int layer, int which, int vb, int nvb) {
  const int lane = otid() & 63, wv = vb * 4 + (otid() >> 6), nwv = nvb * 4;
  const float* mod = (const float*)(p.ws + OFF_MOD) + (long)layer * 9 * 6144;
  const float* g = p.in[which ? 7 : 6] + layer * 1024;
  u16* a = (u16*)(p.ws + OFF_A);
  const bool first = (layer == 0 && which == 0);
  for (int row0 = wv; row0 < MT; row0 += 2 * nwv) {
    const int row1 = row0 + nwv;
    const bool has1 = row1 < MT;
    const float* src[2]; int bb[2];
#pragma unroll
    for (int u = 0; u < 2; ++u) {
      const int row = u == 0 ? row0 : (has1 ? row1 : row0);
      if (row < RL) { bb[u] = row >> 12; src[u] = (first ? p.in[0] : p.out) + (long)row * 1024; }
      else { bb[u] = 8; src[u] = (first ? p.in[2] : (const float*)(p.ws + OFF_HC)) + (long)(row - RL) * 1024; }
    }
    f32x4 v[2][4];
#pragma unroll
    for (int u = 0; u < 2; ++u)
#pragma unroll
      for (int i = 0; i < 4; ++i) v[u][i] = *(const f32x4*)(src[u] + i * 256 + lane * 4);
#pragma unroll
    for (int u = 0; u < 2; ++u) {
      if (u == 1 && !has1) break;
      const int row = u == 0 ? row0 : row1;
      float ss = 0.f;
#pragma unroll
      for (int i = 0; i < 4; ++i) ss += v[u][i][0] * v[u][i][0] + v[u][i][1] * v[u][i][1] + v[u][i][2] * v[u][i][2] + v[u][i][3] * v[u][i][3];
      ss = wave_sum(ss);
      const float rstd = rsqrtf(ss * (1.f / 1024.f) + EPS);
      const float* sh = mod + bb[u] * 6144 + (which ? 3 : 0) * 1024, *sc = sh + 1024;
#pragma unroll
      for (int i = 0; i < 4; ++i) {
        const int k = i * 256 + lane * 4;
        const f32x4 gv = *(const f32x4*)(g + k), scv = *(const f32x4*)(sc + k), shv = *(const f32x4*)(sh + k);
        float o0 = v[u][i][0] * rstd * gv[0] * (1.f + scv[0]) + shv[0], o1 = v[u][i][1] * rstd * gv[1] * (1.f + scv[1]) + shv[1];
        float o2 = v[u][i][2] * rstd * gv[2] * (1.f + scv[2]) + shv[2], o3 = v[u][i][3] * rstd * gv[3] * (1.f + scv[3]) + shv[3];
        *(u32x2*)(a + (long)row * 1024 + k) = (u32x2){pack2(o0, o1), pack2(o2, o3)};
      }
    }
  }
}

DI void final_norm(const Params& p, int vb, int nvb) {
  const int lane = otid() & 63, wv = vb * 4 + (otid() >> 6), nwv = nvb * 4;
  const float* g = p.in[28];
  for (int row0 = wv; row0 < RL; row0 += 2 * nwv) {
    const int row1 = row0 + nwv;
    const bool has1 = row1 < RL;
    float* src0 = p.out + (long)row0 * 1024; float* src1 = p.out + (long)(has1 ? row1 : row0) * 1024;
    f32x4 v0[4], v1[4];
#pragma unroll
    for (int i = 0; i < 4; ++i) { v0[i] = *(const f32x4*)(src0 + i * 256 + lane * 4); v1[i] = *(const f32x4*)(src1 + i * 256 + lane * 4); }
    float ss0 = 0.f, ss1 = 0.f;
#pragma unroll
    for (int i = 0; i < 4; ++i) {
      ss0 += v0[i][0] * v0[i][0] + v0[i][1] * v0[i][1] + v0[i][2] * v0[i][2] + v0[i][3] * v0[i][3];
      ss1 += v1[i][0] * v1[i][0] + v1[i][1] * v1[i][1] + v1[i][2] * v1[i][2] + v1[i][3] * v1[i][3];
    }
    ss0 = wave_sum(ss0); ss1 = wave_sum(ss1);
    const float r0 = rsqrtf(ss0 * (1.f / 1024.f) + EPS), r1 = rsqrtf(ss1 * (1.f / 1024.f) + EPS);
#pragma unroll
    for (int i = 0; i < 4; ++i) {
      const int k = i * 256 + lane * 4;
      const f32x4 gv = *(const f32x4*)(g + k);
      __builtin_nontemporal_store((f32x4){v0[i][0] * r0 * gv[0], v0[i][1] * r0 * gv[1], v0[i][2] * r0 * gv[2], v0[i][3] * r0 * gv[3]}, (f32x4*)(src0 + k));
      if (has1) __builtin_nontemporal_store((f32x4){v1[i][0] * r1 * gv[0], v1[i][1] * r1 * gv[1], v1[i][2] * r1 * gv[2], v1[i][3] * r1 * gv[3]}, (f32x4*)(src1 + k));
    }
  }
}

constexpr int LDT = 32;
constexpr int BUFSZ = 384 * LDT;
template <bool G0, bool G1, bool AKM, bool ROWSS>
DI void kloop(f32x16 (&acc)[2][4], const u16* __restrict__ A, int lda, int K, const u16* __restrict__ Bg0, const u16* __restrict__ Bg1, int ldb,
              u16* As, u16* Bs, float& ss0, float& ss1) {
  const int tid = otid(), lane = tid & 63, wave = tid >> 6, wm = wave >> 1, wn = wave & 1, r32 = lane & 31, hi = lane >> 5;
  u32x4 ra[2], rb0[2], rb1[2];
  const int lrow = tid >> 2, lkc = tid & 3;
  const int tk = tid >> 4, tmc = tid & 15;
#define GLOAD(k0)                                                                                              \
  do {                                                                                                         \
    if (!AKM) { _Pragma("unroll") for (int i = 0; i < 2; ++i) ra[i] = *(const u32x4*)(A + (long)(lrow + 64 * i) * lda + (k0) + lkc * 8); } \
    else      { _Pragma("unroll") for (int i = 0; i < 2; ++i) ra[i] = *(const u32x4*)(A + (long)((k0) + tk + 16 * i) * lda + tmc * 8); }  \
    if (G0) { _Pragma("unroll") for (int i = 0; i < 2; ++i) rb0[i] = *(const u32x4*)(Bg0 + (long)(lrow + 64 * i) * ldb + (k0) + lkc * 8); } \
    if (G1) { _Pragma("unroll") for (int i = 0; i < 2; ++i) rb1[i] = *(const u32x4*)(Bg1 + (long)(lrow + 64 * i) * ldb + (k0) + lkc * 8); } \
  } while (0)
#define SWZ(row, c) ((row) * LDT + (((c) ^ (((row) >> 2) & 3)) << 3))
#define LSTORE(AsD, BsD)                                                                                       \
  do {                                                                                                         \
    if (!AKM) {                                                                                                \
      _Pragma("unroll") for (int i = 0; i < 2; ++i) *(u32x4*)((AsD) + SWZ(lrow + 64 * i, lkc)) = ra[i]; \
      if (ROWSS) {                                                                                             \
        _Pragma("unroll") for (int e = 0; e < 4; ++e) {                                                        \
          float a0 = __uint_as_float(ra[0][e] << 16), a1 = __uint_as_float(ra[0][e] & 0xffff0000u);           \
          float c0 = __uint_as_float(ra[1][e] << 16), c1 = __uint_as_float(ra[1][e] & 0xffff0000u);           \
          ss0 += a0 * a0 + a1 * a1; ss1 += c0 * c0 + c1 * c1;                                                  \
        }                                                                                                      \
      }                                                                                                        \
    } else {                                                                                                   \
      _Pragma("unroll") for (int i = 0; i < 2; ++i) {                                                          \
        _Pragma("unroll") for (int e = 0; e < 8; ++e) (AsD)[SWZ(tmc * 8 + e, (tk + 16 * i) >> 3) + ((tk + 16 * i) & 7)] = (u16)(ra[i][e >> 1] >> (16 * (e & 1))); \
      }                                                                                                        \
    }                                                                                                          \
    if (G0) { _Pragma("unroll") for (int i = 0; i < 2; ++i) *(u32x4*)((BsD) + SWZ(lrow + 64 * i, lkc)) = rb0[i]; }       \
    if (G1) { _Pragma("unroll") for (int i = 0; i < 2; ++i) *(u32x4*)((BsD) + SWZ(128 + lrow + 64 * i, lkc)) = rb1[i]; } \
  } while (0)
  GLOAD(0);
  __syncthreads();
  LSTORE(As, Bs);
  if (32 < K) GLOAD(32);
  __syncthreads();
#pragma unroll 2
  for (int k0 = 0; k0 < K; k0 += 32) {
    const int cur = (k0 >> 5) & 1;
    const u16* Ac = As + cur * BUFSZ; const u16* Bc = Bs + cur * BUFSZ;
    if (k0 + 32 < K) { u16* An = As + (cur ^ 1) * BUFSZ; u16* Bn = Bs + (cur ^ 1) * BUFSZ; LSTORE(An, Bn); }
    if (k0 + 64 < K) GLOAD(k0 + 64);
#pragma unroll
    for (int ks = 0; ks < 2; ++ks) {
      bf16x8 af[2], bfr[4];
#pragma unroll
      for (int i = 0; i < 2; ++i) af[i] = *(const bf16x8*)(Ac + SWZ(wm * 64 + i * 32 + r32, ks * 2 + hi));
      if (G0) {
#pragma unroll
        for (int j = 0; j < 2; ++j) bfr[j] = *(const bf16x8*)(Bc + SWZ(wn * 64 + j * 32 + r32, ks * 2 + hi));
      }
      if (G1) {
#pragma unroll
        for (int j = 0; j < 2; ++j) bfr[2 + j] = *(const bf16x8*)(Bc + SWZ(128 + wn * 64 + j * 32 + r32, ks * 2 + hi));
      }
#pragma unroll
      for (int i = 0; i < 2; ++i) {
        if (G0) { acc[i][0] = MFMA32(af[i], bfr[0], acc[i][0]); acc[i][1] = MFMA32(af[i], bfr[1], acc[i][1]); }
        if (G1) { acc[i][2] = MFMA32(af[i], bfr[2], acc[i][2]); acc[i][3] = MFMA32(af[i], bfr[3], acc[i][3]); }
      }
    }
    __syncthreads();
  }
#undef LSTORE
#undef SWZ
#undef GLOAD
}

#define SWZ(row, c) ((row) * LDT + (((c) ^ (((row) >> 2) & 3)) << 3))
DI void glds16(const u16* g, u16* l) { __builtin_amdgcn_global_load_lds((const unsigned*)g, (unsigned*)l, 16, 0, 0); }
template <bool G0, bool G1, bool ROWSS = false>
DI void kloop_dma(f32x16 (&acc)[2][4], const u16* __restrict__ A, int lda, int K, const u16* __restrict__ Bg0, const u16* __restrict__ Bg1, int ldb, u16* L,
                  float* ssp0 = nullptr, float* ssp1 = nullptr) {
  const int tid = otid(), lane = tid & 63, wave = tid >> 6, wm = wave >> 1, wn = wave & 1, r32 = lane & 31, hi = lane >> 5;
  const int row0 = 16 * wave + (lane >> 2), lc = (lane & 3) ^ ((row0 >> 2) & 3);
  const u16* ga0 = A + (long)row0 * lda + lc * 8; const u16* ga1 = ga0 + (long)64 * lda;
  const u16* gb00 = Bg0 + (long)row0 * ldb + lc * 8; const u16* gb01 = gb00 + (long)64 * ldb;
  const u16* gb10 = Bg1 + (long)row0 * ldb + lc * 8; const u16* gb11 = gb10 + (long)64 * ldb;
  constexpr int NL = 2 + (G0 ? 2 : 0) + (G1 ? 2 : 0);
#define ISSUE(kt, bsel)                                                                              \
  do {                                                                                               \
    u16* Lb = L + (bsel) * BUFSZ; const int ko = (kt) * 32;                                          \
    glds16(ga0 + ko, Lb + wave * 512); glds16(ga1 + ko, Lb + (wave + 4) * 512);                      \
    if (G0) { glds16(gb00 + ko, Lb + 4096 + wave * 512); glds16(gb01 + ko, Lb + 4096 + (wave + 4) * 512); } \
    if (G1) { glds16(gb10 + ko, Lb + 8192 + wave * 512); glds16(gb11 + ko, Lb + 8192 + (wave + 4) * 512); } \
  } while (0)
  asm volatile("s_waitcnt vmcnt(0)" ::: "memory");
  __syncthreads();
  const int nk = K >> 5;
  ISSUE(0, 0);
  if (nk > 1) ISSUE(1, 1);
  auto kstep = [&](int k, auto bufc) __attribute__((always_inline)) {
    constexpr int BUF = decltype(bufc)::value;
    if (k + 1 < nk) asm volatile("s_waitcnt vmcnt(%0)" ::"n"(NL) : "memory"); else asm volatile("s_waitcnt vmcnt(0)" ::: "memory");
    asm volatile("s_waitcnt lgkmcnt(0)" ::: "memory");
    __builtin_amdgcn_s_barrier();
    asm volatile("" ::: "memory");
    const u16* Ac = L + BUF * BUFSZ; const u16* Bc = Ac + 128 * LDT;
    if (ROWSS) {
#pragma unroll
      for (int i = 0; i < 2; ++i) {
        const u32x4 c = *(const u32x4*)(Ac + SWZ((tid >> 2) + 64 * i, tid & 3));
        float sacc = 0.f;
#pragma unroll
        for (int e = 0; e < 4; ++e) { const float a0 = __uint_as_float(c[e] << 16), a1 = __uint_as_float(c[e] & 0xffff0000u); sacc += a0 * a0 + a1 * a1; }
        if (i == 0) *ssp0 += sacc; else *ssp1 += sacc;
      }
    }
#pragma unroll
    for (int ks = 0; ks < 2; ++ks) {
      bf16x8 af[2], bfr[4];
#pragma unroll
      for (int i = 0; i < 2; ++i) af[i] = *(const bf16x8*)(Ac + SWZ(wm * 64 + i * 32 + r32, ks * 2 + hi));
      if (G0) {
#pragma unroll
        for (int j = 0; j < 2; ++j) bfr[j] = *(const bf16x8*)(Bc + SWZ(wn * 64 + j * 32 + r32, ks * 2 + hi));
      }
      if (G1) {
#pragma unroll
        for (int j = 0; j < 2; ++j) bfr[2 + j] = *(const bf16x8*)(Bc + SWZ(128 + wn * 64 + j * 32 + r32, ks * 2 + hi));
      }
      if (ks == 1 && k + 2 < nk) { ISSUE(k + 2, (BUF + 2) % 3); }
      __builtin_amdgcn_s_setprio(1);
#pragma unroll
      for (int i = 0; i < 2; ++i) {
        if (G0) { acc[i][0] = MFMA32(af[i], bfr[0], acc[i][0]); acc[i][1] = MFMA32(af[i], bfr[1], acc[i][1]); }
        if (G1) { acc[i][2] = MFMA32(af[i], bfr[2], acc[i][2]); acc[i][3] = MFMA32(af[i], bfr[3], acc[i][3]); }
      }
      __builtin_amdgcn_s_setprio(0);
    }
  };
  int k3 = 0;
#pragma unroll 1
  for (; k3 + 3 <= nk; k3 += 3) {
    kstep(k3, std::integral_constant<int, 0>{}); kstep(k3 + 1, std::integral_constant<int, 1>{}); kstep(k3 + 2, std::integral_constant<int, 2>{});
  }
  if (k3 < nk) { kstep(k3, std::integral_constant<int, 0>{}); if (k3 + 1 < nk) kstep(k3 + 1, std::integral_constant<int, 1>{}); }
#undef ISSUE
}
#undef SWZ

DI float rope_apply(float v, int r32, int t, const float* rc) {
  const float partner = __shfl_xor(v, 16);
  const float cs = rc[t * 16 + (r32 & 15)], sn = rc[4096 * 16 + t * 16 + (r32 & 15)];
  return r32 < 16 ? v * cs - partner * sn : partner * sn + v * cs;
}

enum { EPI_UIN = 0, EPI_QUP, EPI_KVUP, EPI_G1, EPI_G2, EPI_RES, EPI_FFNIN };

template <int EPI>
DI void gemm_tile(const Params& p, int layer, int mt, int nt, char* smem, int resid_which, int ksl = -1) {
  u16* As = (u16*)smem; u16* Bs = As + 128 * LDT; float* rs = (float*)(As + 3 * BUFSZ);
  const int tid = otid(), lane = tid & 63, wave = tid >> 6, wm = wave >> 1, wn = wave & 1, r32 = lane & 31, hi = lane >> 5;
  const int m0 = mt * 128;
  const bool lat = m0 < RL;
  const int b = lat ? (m0 >> 12) : 8;
  const u16* Wt = (const u16*)(p.ws + OFF_WT);
  f32x16 acc[2][4];
#pragma unroll
  for (int i = 0; i < 2; ++i)
#pragma unroll
    for (int j = 0; j < 4; ++j)
#pragma unroll
      for (int r = 0; r < 16; ++r) acc[i][j][r] = 0.f;
  float ss0 = 0.f, ss1 = 0.f;
  const float* mod = (const float*)(p.ws + OFF_MOD) + ((long)layer * 9 + b) * 6144;
  const float* rc = (const float*)(p.ws + OFF_ROPE);

  if (EPI == EPI_UIN) {
    const u16* A = (const u16*)(p.ws + OFF_A) + (long)m0 * 1024;
    const u16* B0 = Wt + WIN_O + (long)(nt * 256) * 1024;
    kloop_dma<true, true>(acc, A, 1024, 1024, B0, B0 + 128 * 1024, 1024, As);
    u16* uT = (u16*)(p.ws + OFF_UT); u16* cq = (u16*)(p.ws + OFF_CQ); u16* ckv = (u16*)(p.ws + OFF_CKV); u16* kr = (u16*)(p.ws + OFF_KR);
#pragma unroll
    for (int j = 0; j < 4; ++j) {
      const int cb = nt * 256 + (j >> 1) * 128 + wn * 64 + (j & 1) * 32;
      const int col = cb + r32;
#pragma unroll
      for (int i = 0; i < 2; ++i) {
        const int mb = m0 + wm * 64 + i * 32;
        if (cb < 1536) {
#pragma unroll
          for (int g = 0; g < 4; ++g) {
            const u32x2 v = {pack2(acc[i][j][4 * g], acc[i][j][4 * g + 1]), pack2(acc[i][j][4 * g + 2], acc[i][j][4 * g + 3])};
            *(u32x2*)(uT + (long)col * MT + mb + 8 * g + 4 * hi) = v;
          }
        } else if (cb < 1920) {
          float v[16];
#pragma unroll
          for (int r = 0; r < 16; ++r) v[r] = acc[i][j][r];
          store_tile_bf16(cq + (long)mb * QL + (cb - 1536), QL, v, r32, hi);
        } else if (cb < 2176) {
          float v[16];
#pragma unroll
          for (int r = 0; r < 16; ++r) v[r] = acc[i][j][r];
          store_tile_bf16(ckv + (long)mb * KVL + (cb - 1920), KVL, v, r32, hi);
        } else if (cb < 2208) {
          float v[16];
#pragma unroll
          for (int r = 0; r < 16; ++r) {
            v[r] = acc[i][j][r];
            if (lat) v[r] = rope_apply(v[r], r32, (mb + crow(r, hi)) & 4095, rc);
          }
          store_tile_bf16(kr + (long)mb * 32, 32, v, r32, hi);
        } else if (cb < INC) {
          const int gc = col - OFFG;
          const float gbv = p.in[9][layer * 2048 + gc];
          unsigned char* g8 = (unsigned char*)(p.ws + OFF_G8) + (long)gc * MT + mb + 4 * hi;
#pragma unroll
          for (int g = 0; g < 4; ++g) {
            unsigned wv = 0;
#pragma unroll
            for (int e = 0; e < 4; ++e) wv |= (unsigned)(sigmoidf_(acc[i][j][4 * g + e] + gbv) * 255.f + 0.5f) << (8 * e);
            *(unsigned*)(g8 + 8 * g) = wv;
          }
        }
      }
    }
  } else if (EPI == EPI_QUP) {
    const u16* A = (const u16*)(p.ws + OFF_CQ) + (long)m0 * QL;
    const u16* B0 = Wt + WUQ_O + (long)(nt * 256) * QL;
    kloop_dma<true, true, true>(acc, A, QL, QL, B0, B0 + 128 * QL, QL, As, &ss0, &ss1);
    ss0 += __shfl_xor(ss0, 1); ss0 += __shfl_xor(ss0, 2); ss1 += __shfl_xor(ss1, 1); ss1 += __shfl_xor(ss1, 2);
    if ((tid & 3) == 0) { rs[tid >> 2] = rsqrtf(ss0 * (1.f / QL) + EPS); rs[64 + (tid >> 2)] = rsqrtf(ss1 * (1.f / QL) + EPS); }
    __syncthreads();
    u16* q = (u16*)(p.ws + OFF_QN);
#pragma unroll
    for (int j = 0; j < 4; ++j) {
      const int cb = nt * 256 + (j >> 1) * 128 + wn * 64 + (j & 1) * 32;
      const bool isrope = ((cb >> 5) % 3) == 2;
#pragma unroll
      for (int i = 0; i < 2; ++i) {
        const int ml = wm * 64 + i * 32;
        float v[16];
#pragma unroll
        for (int r = 0; r < 16; ++r) {
          const int mrow = ml + crow(r, hi), m = m0 + mrow;
          v[r] = acc[i][j][r] * rs[mrow];
          if (isrope && lat) v[r] = rope_apply(v[r], r32, m & 4095, rc);
        }
        store_tile_bf16(q + (long)(m0 + ml) * 1536 + cb, 1536, v, r32, hi);
      }
    }
    __syncthreads();
  } else if (EPI == EPI_KVUP) {
    const u16* A = (const u16*)(p.ws + OFF_CKV) + (long)m0 * KVL;
    const u16* B0 = Wt + WUKV_O + (long)(nt * 256) * KVL;
    kloop_dma<true, true, true>(acc, A, KVL, KVL, B0, B0 + 128 * KVL, KVL, As, &ss0, &ss1);
    ss0 += __shfl_xor(ss0, 1); ss0 += __shfl_xor(ss0, 2); ss1 += __shfl_xor(ss1, 1); ss1 += __shfl_xor(ss1, 2);
    if ((tid & 3) == 0) { rs[tid >> 2] = rsqrtf(ss0 * (1.f / KVL) + EPS); rs[64 + (tid >> 2)] = rsqrtf(ss1 * (1.f / KVL) + EPS); }
    __syncthreads();
    u16* kn = (u16*)(p.ws + OFF_KN); u16* vT = (u16*)(p.ws + OFF_VT);
    const int bb = lat ? b : ((m0 - RL) >> 8);
    const int key0 = lat ? (m0 & 4095) : (4096 + ((m0 - RL) & 255));
#pragma unroll
    for (int j = 0; j < 4; ++j) {
      const int cb = nt * 256 + (j >> 1) * 128 + wn * 64 + (j & 1) * 32;
      const int h = cb >> 7, sub = (cb >> 5) & 3;
#pragma unroll
      for (int i = 0; i < 2; ++i) {
        const int ml = wm * 64 + i * 32;
        if (sub < 2) {
          float v[16];
#pragma unroll
          for (int r = 0; r < 16; ++r) v[r] = acc[i][j][r] * rs[ml + crow(r, hi)];
          store_tile_bf16(kn + (long)(m0 + ml) * 1024 + h * 64 + sub * 32, 1024, v, r32, hi);
        } else {
          const int dim = (sub - 2) * 32 + r32;
          u16* dst = vT + ((long)(bb * NH + h) * 64 + dim) * KEYS + key0 + ml;
#pragma unroll
          for (int g = 0; g < 4; ++g) {
            const int mr = 8 * g + 4 * hi;
            const u32x2 v = {pack2(acc[i][j][4 * g] * rs[ml + mr], acc[i][j][4 * g + 1] * rs[ml + mr + 1]),
                             pack2(acc[i][j][4 * g + 2] * rs[ml + mr + 2], acc[i][j][4 * g + 3] * rs[ml + mr + 3])};
            *(u32x2*)(dst + mr) = v;
          }
        }
      }
    }
    __syncthreads();
  } else if (EPI == EPI_G1 || EPI == EPI_G2) {
    const int n0 = nt * 128;
    {
      const u16* A1 = (const u16*)(p.ws + OFF_UT) + (long)1024 * MT + m0;
      const u16* Bp = Wt + WHY_O + (long)n0 * 512;
      kloop<true, false, true, false>(acc, A1, MT, 512, Bp, Bp, 512, As, Bs, ss0, ss1);
    }
    {
      const u16* A1 = (const u16*)(p.ws + OFF_UT) + (long)m0 * 1024;
      const u16* Bp = Wt + WMLA_O + (long)n0 * 1024;
      kloop_dma<false, true>(acc, A1, 1024, 1024, Bp, Bp, 1024, As);
    }
    const unsigned char* g8 = (const unsigned char*)(p.ws + OFF_G8);
    u16* mo = (u16*)(p.ws + OFF_VT);
#pragma unroll
    for (int j = 0; j < 2; ++j) {
      const int col = n0 + wn * 64 + j * 32 + r32;
#pragma unroll
      for (int i = 0; i < 2; ++i) {
        const int mb = m0 + wm * 64 + i * 32 + 4 * hi;
        float v[16];
#pragma unroll
        for (int g = 0; g < 4; ++g) {
          const unsigned gh = *(const unsigned*)(g8 + (long)col * MT + mb + 8 * g);
          const unsigned ga = *(const unsigned*)(g8 + (long)(1024 + col) * MT + mb + 8 * g);
#pragma unroll
          for (int e = 0; e < 4; ++e) {
            const float fh = (float)((gh >> (8 * e)) & 255u) * (1.f / 255.f), fa = (float)((ga >> (8 * e)) & 255u) * (1.f / 255.f);
            v[4 * g + e] = fh * acc[i][j][4 * g + e] + fa * acc[i][2 + j][4 * g + e];
          }
        }
        store_tile_bf16(mo + (long)(m0 + wm * 64 + i * 32) * 1024 + n0 + wn * 64 + j * 32, 1024, v, r32, hi);
      }
    }
  } else if (EPI == EPI_RES) {
    const int n0 = nt * 256;
    if (resid_which == 0) {
      const int Ks = ksl < 0 ? 1024 : 128, k0 = ksl < 0 ? 0 : ksl * 128;
      const u16* A = (const u16*)(p.ws + OFF_VT) + (long)m0 * 1024 + k0;
      const u16* B0 = Wt + WOUT_O + (long)n0 * 1024 + k0;
      kloop_dma<true, true>(acc, A, 1024, Ks, B0, B0 + 128 * 1024, 1024, As);
    } else {
      const int Ks = ksl < 0 ? DFF : DFF / 8, k0 = ksl < 0 ? 0 : ksl * (DFF / 8);
      const u16* A = (const u16*)(p.ws + OFF_KN) + (long)m0 * DFF + k0;
      const u16* B0 = Wt + WFOUT_O + (long)n0 * DFF + k0;
      kloop_dma<true, true>(acc, A, DFF, Ks, B0, B0 + 128 * DFF, DFF, As);
    }
    const float* gate = mod + (resid_which ? 5 : 2) * 1024;
    const bool first = (layer == 0 && resid_which == 0);
    const float* hold; float* hnew; long rbase;
    if (lat) { hold = first ? p.in[0] : p.out; hnew = p.out; rbase = m0; }
    else { hold = (const float*)(p.ws + OFF_HC); hnew = (float*)(p.ws + OFF_HC); rbase = m0 - RL; }
    const bool odd = r32 & 1;
#pragma unroll
    for (int j = 0; j < 4; ++j) {
      const int col = n0 + (j >> 1) * 128 + wn * 64 + (j & 1) * 32 + r32;
      const float gv = gate[col];
#pragma unroll
      for (int i = 0; i < 2; ++i) {
        if (ksl < 0) {
#pragma unroll
          for (int rp = 0; rp < 8; ++rp) {
            const float sa = gv * acc[i][j][2 * rp], sb = gv * acc[i][j][2 * rp + 1];
            const float recv = dpp_swap1(odd ? sa : sb);
            const int row = ((2 * rp) & 3) + 8 * ((2 * rp) >> 2) + 4 * hi + (odd ? 1 : 0);
            const long idx = (rbase + wm * 64 + i * 32 + row) * 1024 + (col & ~1);
            const f32x2 h = *(const f32x2*)(hold + idx);
            *(f32x2*)(hnew + idx) = odd ? (f32x2){h[0] + recv, h[1] + sb} : (f32x2){h[0] + sa, h[1] + recv};
          }
        } else {
#pragma unroll
          for (int r = 0; r < 16; ++r) {
            const long idx = (rbase + wm * 64 + i * 32 + crow(r, hi)) * 1024 + col;
            atomicAdd(hnew + idx, gv * acc[i][j][r]);
          }
        }
      }
    }
  } else if (EPI == EPI_FFNIN) {
    const int n0 = nt * 128;
    const u16* A = (const u16*)(p.ws + OFF_A) + (long)m0 * 1024;
    const u16* B0 = Wt + WFIN_O + (long)n0 * 1024;
    kloop_dma<true, true>(acc, A, 1024, 1024, B0, B0 + (long)DFF * 1024, 1024, As);
    u16* act = (u16*)(p.ws + OFF_KN);
#pragma unroll
    for (int j = 0; j < 2; ++j) {
#pragma unroll
      for (int i = 0; i < 2; ++i) {
        float v[16];
#pragma unroll
        for (int r = 0; r < 16; ++r) { const float gte = acc[i][j][r], u = acc[i][2 + j][r]; v[r] = gte * sigmoidf_(gte) * u; }
        store_tile_bf16(act + (long)(m0 + wm * 64 + i * 32) * DFF + n0 + wn * 64 + j * 32, DFF, v, r32, hi);
      }
    }
  }
}

constexpr int KLD = 104, VLD = 72;
DI void attn_item(const Params& p, bool ctxq, int b, int h, int qb, char* smem) {
  constexpr int ABUF = 64 * KLD + 64 * VLD;
  u16* Ks0 = (u16*)smem; float* wsc = (float*)(Ks0 + 3 * ABUF);
  const int tid = otid(), lane = tid & 63, wave = tid >> 6, r32 = lane & 31, hi = lane >> 5;
  float* al = wsc + wave * 128;
  const u16* q = (const u16*)(p.ws + OFF_QN); const u16* kn = (const u16*)(p.ws + OFF_KN); const u16* kr = (const u16*)(p.ws + OFF_KR);
  const u16* vT = (const u16*)(p.ws + OFF_VT) + (long)(b * NH + h) * 64 * KEYS;
  u16* att = (u16*)(p.ws + OFF_UT);
  const long mq0 = ctxq ? (RL + b * 256) : ((long)b * 4096 + qb * 256);
  const int kt0 = ctxq ? 64 : 0, kt1 = 68;
  bf16x8 qf[2][6];
#pragma unroll
  for (int rb = 0; rb < 2; ++rb) {
    const u16* qp = q + (mq0 + wave * 64 + rb * 32 + r32) * 1536 + h * 96 + hi * 8;
#pragma unroll
    for (int d0 = 0; d0 < 6; ++d0) qf[rb][d0] = *(const bf16x8*)(qp + d0 * 16);
  }
  f32x16 o[2][2];
#pragma unroll
  for (int rb = 0; rb < 2; ++rb)
#pragma unroll
    for (int d = 0; d < 2; ++d)
#pragma unroll
      for (int r = 0; r < 16; ++r) o[rb][d][r] = 0.f;
  float m_run[2] = {-1e30f, -1e30f}, l_run[2] = {0.f, 0.f};
  constexpr float C = 0.10206207261596577f * 1.4426950408889634f;
  u16* dump = (u16*)(wsc + 512);
  const u16* gk[4]; int kpitch[4]; const u16* gv[3];
  const long mk00 = ctxq ? (RL + b * 256) : ((long)b * 4096);
#pragma unroll
  for (int i = 0; i < 4; ++i) {
    const int slot = wave + 4 * i, c = slot * 64 + lane;
    const bool real = slot < 13;
    int row = c / 13, part = c - row * 13;
    if (!real) { row = 0; part = 0; }
    if (part == 12) part = 0;
    if (part < 8) { gk[i] = kn + (mk00 + row) * 1024 + h * 64 + part * 8; kpitch[i] = 1024; }
    else { gk[i] = kr + (mk00 + row) * 32 + (part - 8) * 8; kpitch[i] = 32; }
  }
#pragma unroll
  for (int i = 0; i < 3; ++i) {
    const int slot = wave + 4 * i, c = slot * 64 + lane;
    const bool real = slot < 9;
    int dim = c / 9, part = c - dim * 9;
    if (!real) { dim = 0; part = 0; }
    if (part == 8) part = 0;
    gv[i] = vT + (long)dim * KEYS + kt0 * 64 + part * 8;
  }
  const int ctxjump = ctxq ? 0 : (RL + b * 256) - (b * 4096 + 4096);
#define AISSUE(j, bsel)                                                                                    \
  do {                                                                                                     \
    const int rowofs = 64 * (j) + ((kt0 + (j)) >= 64 ? ctxjump : 0);                                       \
    u16* KsD = Ks0 + (bsel) * ABUF; u16* VsD = KsD + 64 * KLD;                                             \
    _Pragma("unroll") for (int i = 0; i < 4; ++i) {                                                        \
      const int slot = wave + 4 * i;                                                                       \
      glds16(gk[i] + (long)rowofs * kpitch[i], slot < 13 ? KsD + slot * 512 : dump);                       \
    }                                                                                                      \
    _Pragma("unroll") for (int i = 0; i < 3; ++i) {                                                        \
      const int slot = wave + 4 * i;                                                                       \
      glds16(gv[i] + 64 * (j), slot < 9 ? VsD + slot * 512 : dump);                                        \
    }                                                                                                      \
  } while (0)
  const int n = kt1 - kt0;
  asm volatile("s_waitcnt vmcnt(0)" ::: "memory");
  __syncthreads();
  AISSUE(0, 0);
  AISSUE(1, 1);
  int buf = 0;
#pragma unroll 1
  for (int j = 0; j < n; ++j) {
    if (j + 1 < n) asm volatile("s_waitcnt vmcnt(7)" ::: "memory"); else asm volatile("s_waitcnt vmcnt(0)" ::: "memory");
    asm volatile("s_waitcnt lgkmcnt(0)" ::: "memory");
    __builtin_amdgcn_s_barrier();
    asm volatile("" ::: "memory");
    if (j + 2 < n) { const int nb = buf == 0 ? 2 : buf - 1; AISSUE(j + 2, nb); }
    const u16* Ks = Ks0 + buf * ABUF; const u16* Vs = Ks + 64 * KLD;
    buf = buf == 2 ? 0 : buf + 1;
    f32x16 pp[2][2];
#pragma unroll
    for (int rb = 0; rb < 2; ++rb)
#pragma unroll
      for (int kb = 0; kb < 2; ++kb)
#pragma unroll
        for (int r = 0; r < 16; ++r) pp[rb][kb][r] = 0.f;
#pragma unroll
    for (int d0 = 0; d0 < 6; ++d0) {
#pragma unroll
      for (int kb = 0; kb < 2; ++kb) {
        const bf16x8 kf = *(const bf16x8*)(Ks + (kb * 32 + r32) * KLD + d0 * 16 + hi * 8);
        pp[0][kb] = MFMA32(kf, qf[0][d0], pp[0][kb]);
        pp[1][kb] = MFMA32(kf, qf[1][d0], pp[1][kb]);
      }
    }
    constexpr float THRS = 8.f / 0.10206207261596577f;
    float pmx[2];
#pragma unroll
    for (int rb = 0; rb < 2; ++rb) {
      float pmax = pp[rb][0][0];
#pragma unroll
      for (int r = 1; r < 16; ++r) pmax = fmaxf(pmax, pp[rb][0][r]);
#pragma unroll
      for (int r = 0; r < 16; ++r) pmax = fmaxf(pmax, pp[rb][1][r]);
      pmx[rb] = fmaxf(pmax, __shfl_xor(pmax, 32));
    }
    const bool keep = __all((pmx[0] - m_run[0] <= THRS) && (pmx[1] - m_run[1] <= THRS));
    float alpha[2] = {1.f, 1.f};
    if (!keep) {
#pragma unroll
      for (int rb = 0; rb < 2; ++rb) {
        const float m_new = fmaxf(m_run[rb], pmx[rb]);
        alpha[rb] = __builtin_amdgcn_exp2f((m_run[rb] - m_new) * C);
        m_run[rb] = m_new;
      }
    }
#pragma unroll
    for (int rb = 0; rb < 2; ++rb) {
      const float mc = -m_run[rb] * C;
      const f32x2 C2 = {C, C}, mc2 = {mc, mc};
      f32x2 ps2 = {0.f, 0.f};
#pragma unroll
      for (int kb = 0; kb < 2; ++kb)
#pragma unroll
        for (int r = 0; r < 16; r += 2) {
          const f32x2 t = __builtin_elementwise_fma((f32x2){pp[rb][kb][r], pp[rb][kb][r + 1]}, C2, mc2);
          const f32x2 e = {__builtin_amdgcn_exp2f(t[0]), __builtin_amdgcn_exp2f(t[1])};
          pp[rb][kb][r] = e[0]; pp[rb][kb][r + 1] = e[1];
          ps2 += e;
        }
      float psum = ps2[0] + ps2[1];
      psum += __shfl_xor(psum, 32);
      l_run[rb] = l_run[rb] * alpha[rb] + psum;
    }
    if (!keep) {
      if (hi == 0) { al[r32] = alpha[0]; al[32 + r32] = alpha[1]; }
      asm volatile("s_waitcnt lgkmcnt(0)" ::: "memory");
#pragma unroll
      for (int rb = 0; rb < 2; ++rb)
#pragma unroll
        for (int r = 0; r < 16; ++r) { const float a = al[rb * 32 + crow(r, hi)]; o[rb][0][r] *= a; o[rb][1][r] *= a; }
    }
#pragma unroll
    for (int s = 0; s < 4; ++s) {
      const int kb = s >> 1, rbs = (s & 1) * 8;
      bf16x8 pa[2];
#pragma unroll
      for (int rb = 0; rb < 2; ++rb) {
        const u32x4 pw = {pack2(pp[rb][kb][rbs], pp[rb][kb][rbs + 1]), pack2(pp[rb][kb][rbs + 2], pp[rb][kb][rbs + 3]),
                          pack2(pp[rb][kb][rbs + 4], pp[rb][kb][rbs + 5]), pack2(pp[rb][kb][rbs + 6], pp[rb][kb][rbs + 7])};
        pa[rb] = __builtin_bit_cast(bf16x8, pw);
      }
#pragma unroll
      for (int d = 0; d < 2; ++d) {
        const u16* vp = Vs + (d * 32 + r32) * VLD + 16 * s + 4 * hi;
        const u32x2 v0 = *(const u32x2*)vp, v1 = *(const u32x2*)(vp + 8);
        const u32x4 vw = {v0[0], v0[1], v1[0], v1[1]};
        const bf16x8 vf = __builtin_bit_cast(bf16x8, vw);
        o[0][d] = MFMA32(pa[0], vf, o[0][d]);
        o[1][d] = MFMA32(pa[1], vf, o[1][d]);
      }
    }
  }
#undef AISSUE
  asm volatile("s_waitcnt lgkmcnt(0)" ::: "memory");
  if (hi == 0) { al[64 + r32] = l_run[0]; al[96 + r32] = l_run[1]; }
  asm volatile("s_waitcnt lgkmcnt(0)" ::: "memory");
#pragma unroll
  for (int rb = 0; rb < 2; ++rb) {
    float il[16];
#pragma unroll
    for (int r = 0; r < 16; ++r) il[r] = __builtin_amdgcn_rcpf(al[64 + rb * 32 + crow(r, hi)]);
#pragma unroll
    for (int d = 0; d < 2; ++d) {
      float v[16];
#pragma unroll
      for (int r = 0; r < 16; ++r) v[r] = o[rb][d][r] * il[r];
      store_tile_bf16(att + (mq0 + wave * 64 + rb * 32) * 1024 + h * 64 + d * 32, 1024, v, r32, hi);
    }
  }
  __syncthreads();
}

constexpr float HY_MIN_DECAY = -3.0701134573253943f, HY_MAX_DECAY = -15.350567286626972f;
DI int phys(int i) { return i + (i >> 4); }
DI unsigned packh2(float a, float b) { f32x2 v = {a, b}; f16x2_t h = __builtin_convertvector(v, f16x2_t); return __builtin_bit_cast(unsigned, h); }
DI f32x2 unpackh2(unsigned u) { f16x2_t h = __builtin_bit_cast(f16x2_t, u); return __builtin_convertvector(h, f32x2); }
DI float opaque(float x) { asm volatile("" : "+v"(x)); return x; }
DI constexpr int brev4(int p) { return ((p & 1) << 3) | ((p & 2) << 1) | ((p & 4) >> 1) | ((p & 8) >> 3); }

DI f32x2 cmul(f32x2 a, f32x2 w) { return (f32x2){a[0] * w[0] - a[1] * w[1], a[0] * w[1] + a[1] * w[0]}; }
template <bool INV, int S>
DI void dft16_stage(f32x2 (&a)[16]) {
  constexpr float C16[8] = {1.f, 0.92387953251128674f, 0.70710678118654752f, 0.38268343236508977f, 0.f, -0.38268343236508977f, -0.70710678118654752f, -0.92387953251128674f};
  constexpr float S16[8] = {0.f, 0.38268343236508977f, 0.70710678118654752f, 0.92387953251128674f, 1.f, 0.92387953251128674f, 0.70710678118654752f, 0.38268343236508977f};
#pragma unroll
  for (int i = 0; i < 16; ++i) {
    if ((i & S) == 0) {
      const int j = i & (S - 1), tw = j * (8 / S);
      const f32x2 u = a[i], v = a[i + S];
      a[i] = u + v;
      const f32x2 d = u - v;
      if (tw == 0) a[i + S] = d;
      else if (tw == 4) a[i + S] = INV ? (f32x2){-d[1], d[0]} : (f32x2){d[1], -d[0]};
      else a[i + S] = cmul(d, (f32x2){C16[tw], INV ? S16[tw] : -S16[tw]});
    }
  }
}
template <bool INV>
DI void dft16(f32x2 (&a)[16]) { dft16_stage<INV, 8>(a); dft16_stage<INV, 4>(a); dft16_stage<INV, 2>(a); dft16_stage<INV, 1>(a); }

template <int S>
DI void idft16_dit_stage(f32x2 (&a)[16]) {
  constexpr float C16[8] = {1.f, 0.92387953251128674f, 0.70710678118654752f, 0.38268343236508977f, 0.f, -0.38268343236508977f, -0.70710678118654752f, -0.92387953251128674f};
  constexpr float S16[8] = {0.f, 0.38268343236508977f, 0.70710678118654752f, 0.92387953251128674f, 1.f, 0.92387953251128674f, 0.70710678118654752f, 0.38268343236508977f};
#pragma unroll
  for (int i = 0; i < 16; ++i) {
    if ((i & S) == 0) {
      const int j = i & (S - 1), tw = j * (8 / S);
      const f32x2 u = a[i];
      f32x2 v = a[i + S];
      if (tw == 4) v = (f32x2){-v[1], v[0]};
      else if (tw != 0) v = cmul(v, (f32x2){C16[tw], S16[tw]});
      a[i] = u + v; a[i + S] = u - v;
    }
  }
}
DI void idft16_dit(f32x2 (&a)[16]) { idft16_dit_stage<1>(a); idft16_dit_stage<2>(a); idft16_dit_stage<4>(a); idft16_dit_stage<8>(a); }

template <int NSUB, bool INV>
DI void fft_pass(f32x2* x) {
  constexpr int m = NSUB / 16;
  const int tid = otid();
  const int j = tid % m;
  f32x2 w[9];
  {
    const float fr = opaque((float)j / (float)NSUB);
    const float c1 = __builtin_amdgcn_cosf(fr), s1 = __builtin_amdgcn_sinf(fr);
    w[0] = (f32x2){1.f, 0.f}; w[1] = (f32x2){c1, INV ? s1 : -s1};
    w[2] = cmul(w[1], w[1]); w[3] = cmul(w[2], w[1]); w[4] = cmul(w[2], w[2]); w[5] = cmul(w[4], w[1]);
    w[6] = cmul(w[4], w[2]); w[7] = cmul(w[4], w[3]); w[8] = cmul(w[4], w[4]);
  }
#pragma unroll
  for (int gi = 0; gi < 2; ++gi) {
    const int g = tid + 256 * gi, b0 = (g / m) * NSUB;
    f32x2 a[16];
    if (!INV) {
#pragma unroll
      for (int q = 0; q < 16; ++q) a[q] = x[phys(b0 + j + q * m)];
      dft16<false>(a);
#pragma unroll
      for (int pp = 0; pp < 16; ++pp) {
        const int r = brev4(pp);
        const f32x2 t = r < 8 ? w[r] : cmul(w[r - 8], w[8]);
        x[phys(b0 + r * m + j)] = cmul(a[pp], t);
      }
    } else {
#pragma unroll
      for (int r = 0; r < 16; ++r) {
        const f32x2 t = r < 8 ? w[r] : cmul(w[r - 8], w[8]);
        a[r] = cmul(x[phys(b0 + r * m + j)], t);
      }
      dft16<true>(a);
#pragma unroll
      for (int pp = 0; pp < 16; ++pp) { const int q = brev4(pp); x[phys(b0 + j + q * m)] = a[pp]; }
    }
  }
}

DI float sconv(const u16* row, long seg, int i, int L, float w0, float w1, float w2, float bb) {
  const float um = i > 0 ? bf2f(row[seg + i - 1]) : 0.f, u0 = bf2f(row[seg + i]), up = i < L - 1 ? bf2f(row[seg + i + 1]) : 0.f;
  return w0 * um + w1 * u0 + w2 * up + bb;
}

DI void hyena_lat_item(const Params& p, int layer, int w, char* smem) {
  f32x2* x = (f32x2*)smem;
  float* sc = (float*)(smem + 8704 * 8);
  const int tid = otid();
  u16* uT = (u16*)(p.ws + OFF_UT);
  u16* vrow = uT + (long)(1024 + w) * MT;
  const float* h2 = (const float*)(p.ws + OFF_H2) + (long)layer * 4096 * 64;
  const float* w3 = p.in[16] + (long)layer * 64 * 2048;
  const float* cw = p.in[10] + layer * 3 * 1536, *cb = p.in[11] + layer * 1536;
  const float absd = -(HY_MIN_DECAY + (float)w * ((HY_MAX_DECAY - HY_MIN_DECAY) / 511.f));
  {
#pragma unroll 1
    for (int rsel = 0; rsel < 3; ++rsel) {
      const int ch = rsel * 512 + w;
      u16* row = uT + (long)ch * MT;
      const float w0 = cw[ch], w1 = cw[1536 + ch], w2 = cw[3072 + ch], bb = cb[ch];
#pragma unroll 1
      for (int g4 = 0; g4 < 2; ++g4) {
        u32x4 o0[4], o1[4];
        const int t16 = otid() * 16;
#pragma unroll
        for (int q = 0; q < 4; ++q) {
          const u16* seg = row + (long)(g4 * 4 + q) * 4096 + t16;
          const u32x4 r0 = *(const u32x4*)seg, r1 = *(const u32x4*)(seg + 8);
          const float hl = t16 > 0 ? bf2f(seg[-1]) : 0.f, hr = t16 < 4080 ? bf2f(seg[16]) : 0.f;
          float u[18];
          u[0] = hl; u[17] = hr;
#pragma unroll
          for (int e = 0; e < 4; ++e) {
            u[1 + 2 * e] = __uint_as_float(r0[e] << 16); u[2 + 2 * e] = __uint_as_float(r0[e] & 0xffff0000u);
            u[9 + 2 * e] = __uint_as_float(r1[e] << 16); u[10 + 2 * e] = __uint_as_float(r1[e] & 0xffff0000u);
          }
          float y[16];
#pragma unroll
          for (int e = 0; e < 16; ++e) y[e] = w0 * u[e] + w1 * u[e + 1] + w2 * u[e + 2] + bb;
          o0[q] = (u32x4){pack2(y[0], y[1]), pack2(y[2], y[3]), pack2(y[4], y[5]), pack2(y[6], y[7])};
          o1[q] = (u32x4){pack2(y[8], y[9]), pack2(y[10], y[11]), pack2(y[12], y[13]), pack2(y[14], y[15])};
        }
        asm volatile("s_waitcnt vmcnt(0)" ::: "memory");
        __syncthreads();
#pragma unroll
        for (int q = 0; q < 4; ++q) {
          u16* seg = row + (long)(g4 * 4 + q) * 4096 + t16;
          *(u32x4*)seg = o0[q]; *(u32x4*)(seg + 8) = o1[q];
        }
      }
    }
    __syncthreads();
  }
  unsigned Hp[2][16];
#pragma unroll 1
  for (int o = 0; o < 2; ++o) {
    const u16* grow = uT + (long)(o * 512 + w) * MT;
    const float bias = p.in[18][(layer * 2 + o) * 512 + w];
    __syncthreads();
    if (tid < 64) sc[16 + tid] = w3[tid * 2048 + o * 512 + w];
    else if (tid < 128) sc[80 + tid - 64] = w3[(tid - 64) * 2048 + 1024 + o * 512 + w];
    __syncthreads();
    float asum = 0.f;
#pragma unroll 4
    for (int k = 0; k < 16; ++k) {
      const int jj = otid() + 256 * k;
      const f32x4* hr = (const f32x4*)(h2 + (long)jj * 64);
      float df = 0.f, db = 0.f;
      int zoff = 0; asm volatile("" : "+v"(zoff));
      const f32x4* scf = (const f32x4*)(sc + 16 + zoff);
#pragma unroll
      for (int q4 = 0; q4 < 16; ++q4) {
        const f32x4 hv = hr[q4], wf = scf[q4], wb = scf[16 + q4];
        df += hv[0] * wf[0] + hv[1] * wf[1] + hv[2] * wf[2] + hv[3] * wf[3];
        db += hv[0] * wb[0] + hv[1] * wb[1] + hv[2] * wb[2] + hv[3] * wb[3];
      }
      const float win = __expf(-((float)jj * (1.f / 4095.f)) * absd);
      const float f = df * win, bk = db * win;
      asum += fabsf(f) + (jj > 0 ? fabsf(bk) : 0.f);
      x[phys(4096 + jj)] = (f32x2){f, bk};
    }
    asum = wave_sum(asum);
    if ((tid & 63) == 0) sc[tid >> 6] = asum;
    __syncthreads();
    const float norm = sc[0] + sc[1] + sc[2] + sc[3];
    {
      float a0[16], a1[16];
#pragma unroll
      for (int k = 0; k < 16; ++k) {
        const int i = otid() + 256 * k;
        a0[k] = x[phys(4096 + i)][0];
        a1[k] = i == 0 ? 0.f : x[phys(8192 - i)][1];
      }
      __syncthreads();
#pragma unroll
      for (int k = 0; k < 16; ++k) {
        const int i = otid() + 256 * k;
        const float fr = opaque((float)i * (1.f / 8192.f));
        const float c = __builtin_amdgcn_cosf(fr), s = __builtin_amdgcn_sinf(fr);
        const float d = a0[k] - a1[k];
        x[phys(i)] = (f32x2){a0[k] + a1[k], 0.f};
        x[phys(4096 + i)] = (f32x2){d * c, -d * s};
      }
    }
    __syncthreads();
    fft_pass<4096, false>(x); __syncthreads();
    fft_pass<256, false>(x); __syncthreads();
    {
      const float scale = 1.f / norm;
#pragma unroll
      for (int gi = 0; gi < 2; ++gi) {
        const int g = otid() + 256 * gi, b0 = g * 16;
        f32x2 a[16];
#pragma unroll
        for (int q = 0; q < 16; ++q) a[q] = x[b0 + q + g];
        dft16<false>(a);
#pragma unroll
        for (int q = 0; q < 16; ++q) Hp[gi][q] = packh2(a[q][0] * scale, a[q][1] * scale);
        __builtin_amdgcn_sched_barrier(0);
      }
    }
    __syncthreads();
#pragma unroll 1
    for (int pr = 0; pr < 4; ++pr) {
      const long s0 = (long)(2 * pr) * 4096, s1 = s0 + 4096;
      {
        const int tt = otid();
        const u16* pv0 = vrow + s0 + tt * 16; const u16* pv1 = vrow + s1 + tt * 16;
        const u32x4 a0 = *(const u32x4*)pv0, a1 = *(const u32x4*)(pv0 + 8), b0v = *(const u32x4*)pv1, b1v = *(const u32x4*)(pv1 + 8);
        const float fr = opaque((float)(tt * 16) * (1.f / 8192.f));
        f32x2 wq = {__builtin_amdgcn_cosf(fr), -__builtin_amdgcn_sinf(fr)};
        const f32x2 dw = {0.99999970588366f, -7.6699031874270e-4f};
        f32x2* xl = x + tt * 17; f32x2* xh = x + 4352 + tt * 17;
#pragma unroll
        for (int k = 0; k < 16; ++k) {
          const unsigned ua = k < 8 ? a0[k >> 1] : a1[(k - 8) >> 1], ub = k < 8 ? b0v[k >> 1] : b1v[(k - 8) >> 1];
          const float re = (k & 1) ? __uint_as_float(ua & 0xffff0000u) : __uint_as_float(ua << 16);
          const float im = (k & 1) ? __uint_as_float(ub & 0xffff0000u) : __uint_as_float(ub << 16);
          const f32x2 z = {re, im};
          xl[k] = z; xh[k] = cmul(z, wq);
          wq = cmul(wq, dw);
        }
      }
      __syncthreads();
      fft_pass<4096, false>(x); __syncthreads();
      fft_pass<256, false>(x); __syncthreads();
#pragma unroll
      for (int gi = 0; gi < 2; ++gi) {
        const int g = otid() + 256 * gi, b0 = g * 16;
        f32x2 a[16];
#pragma unroll
        for (int q = 0; q < 16; ++q) a[q] = x[b0 + q + g];
        dft16<false>(a);
#pragma unroll
        for (int pp = 0; pp < 16; ++pp) a[pp] = cmul(a[pp], unpackh2(Hp[gi][pp]));
        idft16_dit(a);
#pragma unroll
        for (int q = 0; q < 16; ++q) x[b0 + q + g] = a[q];
        __builtin_amdgcn_sched_barrier(0);
      }
      __syncthreads();
      fft_pass<256, true>(x); __syncthreads();
      fft_pass<4096, true>(x); __syncthreads();
      {
        const int tt = otid();
        u16* pv0 = vrow + s0 + tt * 16; u16* pv1 = vrow + s1 + tt * 16;
        const u16* pg0 = grow + s0 + tt * 16; const u16* pg1 = grow + s1 + tt * 16;
        const u32x4 a0 = *(const u32x4*)pv0, a1 = *(const u32x4*)(pv0 + 8), b0v = *(const u32x4*)pv1, b1v = *(const u32x4*)(pv1 + 8);
        const u32x4 c0 = *(const u32x4*)pg0, c1 = *(const u32x4*)(pg0 + 8), d0 = *(const u32x4*)pg1, d1 = *(const u32x4*)(pg1 + 8);
        const float fr = opaque((float)(tt * 16) * (1.f / 8192.f));
        f32x2 wq = {__builtin_amdgcn_cosf(fr), __builtin_amdgcn_sinf(fr)};
        const f32x2 dw = {0.99999970588366f, 7.6699031874270e-4f};
        const f32x2* xl = x + tt * 17; const f32x2* xh = x + 4352 + tt * 17;
        float r0[16], r1[16];
#pragma unroll
        for (int k = 0; k < 16; ++k) {
          const f32x2 y = (xl[k] + cmul(xh[k], wq)) * (1.f / 8192.f);
          wq = cmul(wq, dw);
          const unsigned ua = k < 8 ? a0[k >> 1] : a1[(k - 8) >> 1], ub = k < 8 ? b0v[k >> 1] : b1v[(k - 8) >> 1];
          const unsigned uc = k < 8 ? c0[k >> 1] : c1[(k - 8) >> 1], ud = k < 8 ? d0[k >> 1] : d1[(k - 8) >> 1];
          const float v0 = (k & 1) ? __uint_as_float(ua & 0xffff0000u) : __uint_as_float(ua << 16);
          const float v1 = (k & 1) ? __uint_as_float(ub & 0xffff0000u) : __uint_as_float(ub << 16);
          const float g0 = (k & 1) ? __uint_as_float(uc & 0xffff0000u) : __uint_as_float(uc << 16);
          const float g1 = (k & 1) ? __uint_as_float(ud & 0xffff0000u) : __uint_as_float(ud << 16);
          r0[k] = g0 * (y[0] + bias * v0); r1[k] = g1 * (y[1] + bias * v1);
        }
        *(u32x4*)pv0 = (u32x4){pack2(r0[0], r0[1]), pack2(r0[2], r0[3]), pack2(r0[4], r0[5]), pack2(r0[6], r0[7])};
        *(u32x4*)(pv0 + 8) = (u32x4){pack2(r0[8], r0[9]), pack2(r0[10], r0[11]), pack2(r0[12], r0[13]), pack2(r0[14], r0[15])};
        *(u32x4*)pv1 = (u32x4){pack2(r1[0], r1[1]), pack2(r1[2], r1[3]), pack2(r1[4], r1[5]), pack2(r1[6], r1[7])};
        *(u32x4*)(pv1 + 8) = (u32x4){pack2(r1[8], r1[9]), pack2(r1[10], r1[11]), pack2(r1[12], r1[13]), pack2(r1[14], r1[15])};
      }
      __syncthreads();
    }
  }
  __syncthreads();
}

DI void hyena_ctx_item(const Params& p, int w, char* smem) {
  float* F = (float*)smem; float* Bk = F + 256; float* vin = Bk + 256; float* sc = vin + 256;
  const int tid = otid(), t = tid;
  u16* uT = (u16*)(p.ws + OFF_UT);
  u16* vrow = uT + (long)(1024 + w) * MT + RL;
  const float* h2c = (const float*)(p.ws + OFF_H2C);
  const float* w3 = p.in[16];
  const float* cw = p.in[10], *cb = p.in[11];
  const float absd = -(HY_MIN_DECAY + (float)w * ((HY_MAX_DECAY - HY_MIN_DECAY) / 511.f));
  const float vw0 = cw[1024 + w], vw1 = cw[1536 + 1024 + w], vw2 = cw[3072 + 1024 + w], vbb = cb[1024 + w];
  float vv[8];
#pragma unroll
  for (int b = 0; b < 8; ++b) vv[b] = sconv(vrow, (long)b * 256, t, 256, vw0, vw1, vw2, vbb);
#pragma unroll 1
  for (int o = 0; o < 2; ++o) {
    const u16* grow = uT + (long)(o * 512 + w) * MT + RL;
    const float gw0 = cw[o * 512 + w], gw1 = cw[1536 + o * 512 + w], gw2 = cw[3072 + o * 512 + w], gbb = cb[o * 512 + w];
    const float bias = p.in[18][o * 512 + w];
    __syncthreads();
    {
      float df = 0.f, db = 0.f;
      for (int k = 0; k < 64; ++k) { const float hv = h2c[t * 64 + k]; df += hv * w3[k * 2048 + o * 512 + w]; db += hv * w3[k * 2048 + 1024 + o * 512 + w]; }
      const float win = __expf(-((float)t * (1.f / 255.f)) * absd);
      const float f = df * win, bk = db * win;
      F[t] = f; Bk[t] = bk;
      float asum = fabsf(f) + (t > 0 ? fabsf(bk) : 0.f);
      asum = wave_sum(asum);
      if ((tid & 63) == 0) sc[tid >> 6] = asum;
    }
    __syncthreads();
    const float inorm = 1.f / (sc[0] + sc[1] + sc[2] + sc[3]);
#pragma unroll
    for (int b = 0; b < 8; ++b) {
      vin[t] = vv[b];
      __syncthreads();
      float y = 0.f;
      for (int s = 0; s <= t; ++s) y += F[t - s] * vin[s];
      for (int s = t + 1; s < 256; ++s) y += Bk[s - t] * vin[s];
      const float g = sconv(grow, (long)b * 256, t, 256, gw0, gw1, gw2, gbb);
      vv[b] = g * (y * inorm + bias * vv[b]);
      __syncthreads();
    }
  }
#pragma unroll
  for (int b = 0; b < 8; ++b) vrow[(long)b * 256 + t] = f2bf(vv[b]);
  __syncthreads();
}

constexpr int NPHASE = 20;
constexpr int MTILES = MT / 128, LTILES = RL / 128;

DI void run_phase(const Params& pin, int ph, char* smem, int vb, int nvb) {
  Params p = pin;
  asm volatile("" : "+s"(p.ws), "+s"(p.out));
  if (ph == 0) {
    for (int it = vb; it < 4096 + 192 + 2112 + 256 + 256; it += nvb) {
      if (it < 4096) wconv_item(p, 0, it, smem);
      else if (it < 4288) mod_item(p, it - 4096, smem);
      else if (it < 6400) h2_item(p, it - 4288, smem);
      else if (it < 6656) rope_item(p, it - 6400);
      else {
        const f32x4* src = (const f32x4*)p.in[2] + (long)(it - 6656) * 2048; f32x4* dst = (f32x4*)(p.ws + OFF_HC) + (long)(it - 6656) * 2048;
        for (int k = otid(); k < 2048; k += 256) dst[k] = src[k];
      }
    }
    return;
  }
  if (ph == NPHASE - 1) { final_norm(p, vb, nvb); return; }
  const int layer = (ph - 1) / 9, sub = (ph - 1) % 9;
  const int mtl = layer == 0 ? MTILES : LTILES;
#define TILE_LOOP(T, NT, OFFS, CALL)                                                     \
  for (int it_ = vb; it_ < ((T) + nvb - 1) / nvb * nvb; it_ += nvb) {                     \
    const int tl_ = ((it_ / nvb) * 8 + (vb & 7)) * (nvb >> 3) + (vb >> 3);                \
    if (tl_ < (T)) {                                                                      \
      const int sr_ = tl_ / (8 * (NT)), rem_ = tl_ - sr_ * 8 * (NT);                      \
      const int nt = rem_ >> 3, mt = (OFFS) + sr_ * 8 + (rem_ & 7);                       \
      CALL;                                                                               \
    }                                                                                     \
  }
  switch (sub) {
    case 0:
      norm_rows(p, layer, 0, vb, nvb);
      if (layer == 1) for (int it = vb; it < 4096; it += nvb) wconv_item(p, 1, it, smem);
      break;
    case 1: {
      TILE_LOOP(mtl * 17, 17, 0, gemm_tile<EPI_UIN>(p, layer, mt, nt, smem, 0))
      if (layer == 1) for (int e = vb; e < (MTILES - LTILES) * 2; e += nvb) gemm_tile<EPI_UIN>(p, layer, LTILES + (e >> 1), 7 + (e & 1), smem, 0);
    } break;
    case 2: {
      const int nhy = layer == 0 ? 1024 : 512;
      const bool gemm_first = vb >= (nvb >> 1);
#pragma unroll 1
      for (int pass = 0; pass < 2; ++pass) {
        if ((pass == 0) != gemm_first) {
          for (int it = vb; it < nhy; it += nvb) {
            if (it < 512) hyena_lat_item(p, layer, it, smem);
            else hyena_ctx_item(p, it - 512, smem);
          }
        } else {
          TILE_LOOP(mtl * 6, 6, 0, gemm_tile<EPI_QUP>(p, layer, mt, nt, smem, 0))
          TILE_LOOP(MTILES * 8, 8, 0, gemm_tile<EPI_KVUP>(p, layer, mt, nt, smem, 0))
        }
      }
    } break;
    case 3: {
      const int nlat = NBATCH * NH * 16, nctx = layer == 0 ? NBATCH * NH : 0;
      for (int it_ = vb; it_ < (nlat + nvb - 1) / nvb * nvb; it_ += nvb) {
        const int it = ((it_ / nvb) * 8 + (vb & 7)) * (nvb >> 3) + (vb >> 3);
        if (it < nlat) attn_item(p, false, it >> 8, (it >> 4) & 15, it & 15, smem);
      }
      for (int e = vb; e < nctx; e += nvb) attn_item(p, true, e >> 4, e & 15, 0, smem);
    } break;
    case 4: TILE_LOOP(mtl * 8, 8, 0, gemm_tile<EPI_G1>(p, layer, mt, nt, smem, 0)) break;
    case 5:
      TILE_LOOP(LTILES * 4, 4, 0, gemm_tile<EPI_RES>(p, layer, mt, nt, smem, 0))
      if (layer == 0) for (int e = vb; e < (MTILES - LTILES) * 4 * 8; e += nvb) gemm_tile<EPI_RES>(p, layer, LTILES + (e >> 5), (e >> 3) & 3, smem, 0, e & 7);
      break;
    case 6: norm_rows(p, layer, 1, vb, nvb); break;
    case 7: TILE_LOOP(mtl * 22, 22, 0, gemm_tile<EPI_FFNIN>(p, layer, mt, nt, smem, 0)) break;
    case 8:
      TILE_LOOP(LTILES * 4, 4, 0, gemm_tile<EPI_RES>(p, layer, mt, nt, smem, 1))
      if (layer == 0) for (int e = vb; e < (MTILES - LTILES) * 4 * 8; e += nvb) gemm_tile<EPI_RES>(p, layer, LTILES + (e >> 5), (e >> 3) & 3, smem, 1, e & 7);
      break;
  }
#undef TILE_LOOP
}

DI void fast_grid_sync(unsigned* ctr, unsigned target) {
  asm volatile("s_waitcnt vmcnt(0)" ::: "memory");
  __syncthreads();
  if (threadIdx.x == 0) {
    __builtin_amdgcn_fence(__ATOMIC_RELEASE, "agent");
    asm volatile("s_waitcnt vmcnt(0)" ::: "memory");
    __hip_atomic_fetch_add(ctr, 1u, __ATOMIC_RELAXED, __HIP_MEMORY_SCOPE_AGENT);
    while (__hip_atomic_load(ctr, __ATOMIC_RELAXED, __HIP_MEMORY_SCOPE_AGENT) < target) __builtin_amdgcn_s_sleep(1);
    __builtin_amdgcn_fence(__ATOMIC_ACQUIRE, "agent");
    asm volatile("s_waitcnt vmcnt(0)" ::: "memory");
  }
  __syncthreads();
}

__global__ void __launch_bounds__(NTHREADS, 2) mega_kernel(Params p) {
  extern __shared__ __attribute__((aligned(16))) char smem[];
  cg::grid_group grid = cg::this_grid();
  for (int ph = 0; ph < NPHASE; ++ph) {
    run_phase(p, ph, smem, blockIdx.x, gridDim.x);
    if (ph == 0) {
      if (blockIdx.x == 0 && threadIdx.x == 0) __hip_atomic_store((unsigned*)(p.ws + OFF_BAR), 0u, __ATOMIC_RELAXED, __HIP_MEMORY_SCOPE_AGENT);
      grid.sync();
    } else if (ph + 1 < NPHASE) {
      fast_grid_sync((unsigned*)(p.ws + OFF_BAR), (unsigned)ph * gridDim.x);
    }
  }
}

#if MULTI_LAUNCH
__global__ void __launch_bounds__(NTHREADS, 2) phase_kernel(Params p, int ph) {
  extern __shared__ __attribute__((aligned(16))) char smem[];
  run_phase(p, ph, smem, blockIdx.x, gridDim.x);
}
#endif

extern "C" void kernel_launch(void* const* d_in, const int* in_sizes, int n_in, void* d_out, int out_size, void* d_ws, size_t ws_size,
                              hipStream_t stream) {
  static int grid_blocks = 0;
  if (!grid_blocks) {
    int dev = 0, cus = 0, per_cu = 0;
    (void)hipGetDevice(&dev);
    (void)hipDeviceGetAttribute(&cus, hipDeviceAttributeMultiprocessorCount, dev);
    (void)hipFuncSetAttribute((const void*)mega_kernel, hipFuncAttributeMaxDynamicSharedMemorySize, LDS_BYTES);
#if MULTI_LAUNCH
    (void)hipFuncSetAttribute((const void*)phase_kernel, hipFuncAttributeMaxDynamicSharedMemorySize, LDS_BYTES);
#endif
    (void)hipOccupancyMaxActiveBlocksPerMultiprocessor(&per_cu, mega_kernel, NTHREADS, LDS_BYTES);
    if (per_cu < 1) per_cu = 1;
    if (per_cu > 2) per_cu = 2;
    grid_blocks = cus * per_cu;
  }
  Params p{};
  for (int i = 0; i < 29; ++i) p.in[i] = (const float*)d_in[i];
  p.out = (float*)d_out;
  p.ws = (char*)d_ws;
  if (ws_size < WS_END + 256) { fprintf(stderr, "workspace too small\n"); return; }
#if MULTI_LAUNCH
  for (int ph = 0; ph < NPHASE; ++ph) hipLaunchKernelGGL(phase_kernel, dim3(grid_blocks), dim3(NTHREADS), LDS_BYTES, stream, p, ph);
#else
  void* args[] = {&p};
  hipError_t e = hipLaunchCooperativeKernel((void*)mega_kernel, dim3(grid_blocks), dim3(NTHREADS), args, LDS_BYTES, stream);
  if (e != hipSuccess) fprintf(stderr, "cooperative launch failed: %s (grid %d)\n", hipGetErrorString(e), grid_blocks);
#endif
}
```

```cpp
#include <hip/hip_runtime.h>
#include <hip/hip_cooperative_groups.h>
#include <cstdio>
#include <type_traits>
namespace cg = cooperative_groups;

#ifndef MULTI_LAUNCH
#define MULTI_LAUNCH 0
#endif

#define DI __device__ __forceinline__
typedef unsigned short u16;
typedef __attribute__((ext_vector_type(8))) short bf16x8;
typedef __attribute__((ext_vector_type(16))) float f32x16;
typedef __attribute__((ext_vector_type(4))) float f32x4;
typedef __attribute__((ext_vector_type(2))) float f32x2;
typedef __attribute__((ext_vector_type(4))) unsigned u32x4;
typedef __attribute__((ext_vector_type(2))) unsigned u32x2;
typedef __attribute__((ext_vector_type(2))) __bf16 bf16x2_t;
typedef __attribute__((ext_vector_type(2))) _Float16 f16x2_t;

constexpr int DM = 1024, NBATCH = 8, SEQ = 4096, CTXL = 256;
constexpr int RL = NBATCH * SEQ, RC = NBATCH * CTXL, MT = RL + RC;
constexpr int HYW = 512, QL = 384, KVL = 256, NH = 16, DFF = 2816;
constexpr int KEYS = SEQ + CTXL;
constexpr int INC = 4256, OFFG = 2208;
constexpr float EPS = 1e-6f;
constexpr int LDS_BYTES = 74752;
constexpr int NTHREADS = 256;

constexpr size_t SZ_Q = (size_t)MT * 1536 * 2, SZ_A = (size_t)MT * 1024 * 2, SZ_CQ = (size_t)MT * QL * 2,
                 SZ_CKV = (size_t)MT * KVL * 2, SZ_KR = (size_t)MT * 32 * 2, SZ_UT = (size_t)1536 * MT * 2;
constexpr size_t OFF_Q = 0, OFF_A = OFF_Q + SZ_Q, OFF_CQ = OFF_A + SZ_A, OFF_CKV = OFF_CQ + SZ_CQ, OFF_KR = OFF_CKV + SZ_CKV,
                 OFF_KN = OFF_KR + SZ_KR, OFF_VT = OFF_KN + SZ_A, OFF_UT = OFF_VT + SZ_A, OFF_WT = OFF_UT + SZ_UT;
constexpr long WIN_O = 0, WUQ_O = WIN_O + 4256L * 1024, WUKV_O = WUQ_O + 1536L * 384, WHY_O = WUKV_O + 2048L * 256,
               WMLA_O = WHY_O + 1024L * 512, WOUT_O = WMLA_O + 1024L * 1024, WFIN_O = WOUT_O + 1024L * 1024,
               WFOUT_O = WFIN_O + 5632L * 1024, WT_ELEMS = WFOUT_O + 1024L * 2816;
constexpr size_t OFF_HC = OFF_WT + (size_t)WT_ELEMS * 2, OFF_MOD = OFF_HC + (size_t)RC * 1024 * 4,
                 OFF_H2 = OFF_MOD + (size_t)2 * 9 * 6144 * 4, OFF_H2C = OFF_H2 + (size_t)2 * 4096 * 64 * 4,
                 OFF_ROPE = OFF_H2C + (size_t)256 * 64 * 4, WS_END = OFF_ROPE + (size_t)2 * 4096 * 16 * 4;
constexpr size_t OFF_G8 = OFF_Q;
constexpr size_t OFF_QN = OFF_Q + SZ_A;
static_assert(OFF_QN + SZ_Q == OFF_CQ, "q must end where cq starts");
static_assert((size_t)2048 * MT <= SZ_A, "gate8 fits below q");
constexpr size_t OFF_BAR = WS_END;
static_assert(WS_END + 256 <= 536870912ull, "workspace too large");
static_assert((size_t)MT * DFF * 2 <= SZ_A * 2 + SZ_UT, "act does not fit");

struct Params {
  const float* in[29];
  float* out;
  char* ws;
};

DI int otid() { int t = threadIdx.x; asm volatile("" : "+v"(t)); return t; }
DI unsigned pack2(float lo, float hi) { f32x2 v = {lo, hi}; bf16x2_t b = __builtin_convertvector(v, bf16x2_t); return __builtin_bit_cast(unsigned, b); }
DI u16 f2bf(float x) { return (u16)(pack2(x, 0.f) & 0xffffu); }
DI float bf2f(u16 b) { return __uint_as_float((unsigned)b << 16); }
DI int crow(int r, int hi) { return (r & 3) + 8 * (r >> 2) + 4 * hi; }
DI float sigmoidf_(float x) { return __builtin_amdgcn_rcpf(1.f + __expf(-x)); }
DI float wave_sum(float v) {
#pragma unroll
  for (int o = 32; o >= 1; o >>= 1) v += __shfl_xor(v, o);
  return v;
}
DI float dpp_swap1(float v) { return __builtin_bit_cast(float, __builtin_amdgcn_mov_dpp(__builtin_bit_cast(int, v), 0xB1, 0xF, 0xF, true)); }
DI void store_tile_bf16(u16* dst, long ld, const float (&v)[16], int r32, int hi) {
  const bool odd = r32 & 1;
#pragma unroll
  for (int rp = 0; rp < 8; ++rp) {
    const float a = v[2 * rp], b = v[2 * rp + 1];
    const float recv = dpp_swap1(odd ? a : b);
    const int row = ((2 * rp) & 3) + 8 * ((2 * rp) >> 2) + 4 * hi + (odd ? 1 : 0);
    const unsigned w = odd ? pack2(recv, b) : pack2(a, recv);
    *(unsigned*)(dst + (long)row * ld + (r32 & ~1)) = w;
  }
}
#define MFMA32(a, b, c) __builtin_amdgcn_mfma_f32_32x32x16_bf16((a), (b), (c), 0, 0, 0)

DI void wconv_item(const Params& p, int layer, int it, char* smem) {
  int K, N; const float* W; const float* g = nullptr; long woff;
  if (it < 1072) { K = 1024; N = 4256; W = p.in[8] + (long)layer * 1024 * 4256; woff = WIN_O; }
  else if ((it -= 1072) < 144) { K = 384; N = 1536; W = p.in[22] + (long)layer * 384 * 1536; g = p.in[20] + layer * 384; woff = WUQ_O; }
  else if ((it -= 144) < 128) { K = 256; N = 2048; W = p.in[23] + (long)layer * 256 * 2048; g = p.in[21] + layer * 256; woff = WUKV_O; }
  else if ((it -= 128) < 128) { K = 512; N = 1024; W = p.in[19] + (long)layer * 512 * 1024; woff = WHY_O; }
  else if ((it -= 128) < 256) { K = 1024; N = 1024; W = p.in[24] + (long)layer * 1024 * 1024; woff = WMLA_O; }
  else if ((it -= 256) < 256) { K = 1024; N = 1024; W = p.in[25] + (long)layer * 1024 * 1024; woff = WOUT_O; }
  else if ((it -= 256) < 1408) { K = 1024; N = 5632; W = p.in[26] + (long)layer * 1024 * 5632; woff = WFIN_O; }
  else { it -= 1408; K = 2816; N = 1024; W = p.in[27] + (long)layer * 2816 * 1024; woff = WFOUT_O; }
  const int nts = (N + 63) >> 6;
  const int kt = it / nts, nt = it - kt * nts;
  u16* tile = (u16*)smem;
  u16* Wt = (u16*)(p.ws + OFF_WT) + woff;
  const int tid = otid();
  {
    const int r = tid >> 4, c4 = tid & 15;
#pragma unroll
    for (int i = 0; i < 4; ++i) {
      const int kk = r + 16 * i, k = kt * 64 + kk, n = nt * 64 + c4 * 4;
      f32x4 v = {0.f, 0.f, 0.f, 0.f};
      if (n < N) v = *(const f32x4*)(W + (long)k * N + n);
      const float s = g ? g[k] : 1.f;
      tile[kk * 66 + c4 * 4 + 0] = f2bf(v[0] * s); tile[kk * 66 + c4 * 4 + 1] = f2bf(v[1] * s);
      tile[kk * 66 + c4 * 4 + 2] = f2bf(v[2] * s); tile[kk * 66 + c4 * 4 + 3] = f2bf(v[3] * s);
    }
  }
  __syncthreads();
  {
    const int n = tid >> 2, kc = tid & 3;
    if (nt * 64 + n < N) {
      unsigned w[8];
#pragma unroll
      for (int e = 0; e < 8; ++e) w[e] = (unsigned)tile[(kc * 16 + 2 * e) * 66 + n] | ((unsigned)tile[(kc * 16 + 2 * e + 1) * 66 + n] << 16);
      u32x4* dst = (u32x4*)(Wt + (long)(nt * 64 + n) * K + kt * 64 + kc * 16);
      dst[0] = (u32x4){w[0], w[1], w[2], w[3]}; dst[1] = (u32x4){w[4], w[5], w[6], w[7]};
    }
  }
  __syncthreads();
}

DI void mod_item(const Params& p, int it, char* smem) {
  const int layer = it / 96, n0 = (it % 96) * 64, tid = otid();
  float* s = (float*)smem;
  float* red = s + 9216;
  for (int idx = tid; idx < 9216; idx += 256) {
    const int r = idx >> 10, k = idx & 1023;
    const float cv = r < 8 ? p.in[1][r * 1024 + k] : p.in[3][k];
    s[idx] = cv / (1.f + expf(-cv));
  }
  __syncthreads();
  const int kq = tid >> 6, nn = tid & 63;
  float acc[9];
#pragma unroll
  for (int r = 0; r < 9; ++r) acc[r] = 0.f;
  const float* W = p.in[4] + (long)layer * 1024 * 6144 + n0 + nn;
  for (int k = kq; k < 1024; k += 4) {
    const float w = W[(long)k * 6144];
#pragma unroll
    for (int r = 0; r < 9; ++r) acc[r] += s[r * 1024 + k] * w;
  }
#pragma unroll
  for (int r = 0; r < 9; ++r) red[(kq * 9 + r) * 64 + nn] = acc[r];
  __syncthreads();
  float* mod = (float*)(p.ws + OFF_MOD);
  for (int idx = tid; idx < 576; idx += 256) {
    const int r = idx >> 6, c = idx & 63;
    float v = p.in[5][layer * 6144 + n0 + c];
#pragma unroll
    for (int q = 0; q < 4; ++q) v += red[(q * 9 + r) * 64 + c];
    mod[(layer * 9 + r) * 6144 + n0 + c] = v;
  }
  __syncthreads();
}

DI void h2_item(const Params& p, int it, char* smem) {
  int set, row4;
  if (it < 1024) { set = 0; row4 = it; } else if (it < 2048) { set = 1; row4 = it - 1024; } else { set = 2; row4 = it - 2048; }
  const int L = set < 2 ? 4096 : 256, layer = set == 1 ? 1 : 0;
  float* dst = set < 2 ? (float*)(p.ws + OFF_H2) + (long)set * 4096 * 64 : (float*)(p.ws + OFF_H2C);
  const int tid = otid(), rr = tid >> 6, c = tid & 63, row = row4 * 4 + rr;
  const float t = (float)row / (float)(L - 1);
  float* zs = (float*)smem;
  float* h1s = zs + 4 * 36;
  if (c < 33) {
    float val;
    if (c == 0) val = t; else if (c <= 16) val = cospif(2.f * (float)c * t); else val = sinpif(2.f * (float)(c - 16) * t);
    zs[rr * 36 + c] = val;
  }
  __syncthreads();
  const float* w1 = p.in[12] + layer * 33 * 64, *b1 = p.in[13] + layer * 64, *w2 = p.in[14] + layer * 64 * 64, *b2 = p.in[15] + layer * 64;
  const float* fr = p.in[17] + layer * 128;
  float a = b1[c];
  for (int i = 0; i < 33; ++i) a += zs[rr * 36 + i] * w1[i * 64 + c];
  h1s[rr * 64 + c] = sinf(fr[c] * a);
  __syncthreads();
  a = b2[c];
  for (int k = 0; k < 64; ++k) a += h1s[rr * 64 + k] * w2[k * 64 + c];
  dst[(long)row * 64 + c] = sinf(fr[64 + c] * a);
  __syncthreads();
}

DI void rope_item(const Params& p, int it) {
  const int idx = it * 256 + otid(), t = idx >> 4, i = idx & 15;
  const float pos = (float)(i < 8 ? (t >> 6) : (t & 63));
  const float inv = exp2f(-(float)(i & 7) * (13.287712379549449f / 8.f));
  float sn, cs; sincosf(pos * inv, &sn, &cs);
  float* rc = (float*)(p.ws + OFF_ROPE);
  rc[idx] = cs; rc[4096 * 16 + idx] = sn;
}

DI void norm_rows(const Params& p, int layer, int which, int vb, int nvb) {
  const int lane = otid() & 63, wv = vb * 4 + (otid() >> 6), nwv = nvb * 4;
  const float* mod = (const float*)(p.ws + OFF_MOD) + (long)layer * 9 * 6144;
  const float* g = p.in[which ? 7 : 6] + layer * 1024;
  u16* a = (u16*)(p.ws + OFF_A);
  const bool first = (layer == 0 && which == 0);
  for (int row0 = wv; row0 < MT; row0 += 2 * nwv) {
    const int row1 = row0 + nwv;
    const bool has1 = row1 < MT;
    const float* src[2]; int bb[2];
#pragma unroll
    for (int u = 0; u < 2; ++u) {
      const int row = u == 0 ? row0 : (has1 ? row1 : row0);
      if (row < RL) { bb[u] = row >> 12; src[u] = (first ? p.in[0] : p.out) + (long)row * 1024; }
      else { bb[u] = 8; src[u] = (first ? p.in[2] : (const float*)(p.ws + OFF_HC)) + (long)(row - RL) * 1024; }
    }
    f32x4 v[2][4];
#pragma unroll
    for (int u = 0; u < 2; ++u)
#pragma unroll
      for (int i = 0; i < 4; ++i) v[u][i] = *(const f32x4*)(src[u] + i * 256 + lane * 4);
#pragma unroll
    for (int u = 0; u < 2; ++u) {
      if (u == 1 && !has1) break;
      const int row = u == 0 ? row0 : row1;
      float ss = 0.f;
#pragma unroll
      for (int i = 0; i < 4; ++i) ss += v[u][i][0] * v[u][i][0] + v[u][i][1] * v[u][i][1] + v[u][i][2] * v[u][i][2] + v[u][i][3] * v[u][i][3];
      ss = wave_sum(ss);
      const float rstd = rsqrtf(ss * (1.f / 1024.f) + EPS);
      const float* sh = mod + bb[u] * 6144 + (which ? 3 : 0) * 1024, *sc = sh + 1024;
#pragma unroll
      for (int i = 0; i < 4; ++i) {
        const int k = i * 256 + lane * 4;
        const f32x4 gv = *(const f32x4*)(g + k), scv = *(const f32x4*)(sc + k), shv = *(const f32x4*)(sh + k);
        float o0 = v[u][i][0] * rstd * gv[0] * (1.f + scv[0]) + shv[0], o1 = v[u][i][1] * rstd * gv[1] * (1.f + scv[1]) + shv[1];
        float o2 = v[u][i][2] * rstd * gv[2] * (1.f + scv[2]) + shv[2], o3 = v[u][i][3] * rstd * gv[3] * (1.f + scv[3]) + shv[3];
        *(u32x2*)(a + (long)row * 1024 + k) = (u32x2){pack2(o0, o1), pack2(o2, o3)};
      }
    }
  }
}

DI void final_norm(const Params& p, int vb, int nvb) {
  const int lane = otid() & 63, wv = vb * 4 + (otid() >> 6), nwv = nvb * 4;
  const float* g = p.in[28];
  for (int row = wv; row < RL; row += nwv) {
    float* src = p.out + (long)row * 1024;
    f32x4 v[4]; float ss = 0.f;
#pragma unroll
    for (int i = 0; i < 4; ++i) { v[i] = *(const f32x4*)(src + i * 256 + lane * 4); ss += v[i][0] * v[i][0] + v[i][1] * v[i][1] + v[i][2] * v[i][2] + v[i][3] * v[i][3]; }
    ss = wave_sum(ss);
    const float rstd = rsqrtf(ss * (1.f / 1024.f) + EPS);
#pragma unroll
    for (int i = 0; i < 4; ++i) {
      const int k = i * 256 + lane * 4;
      const f32x4 gv = *(const f32x4*)(g + k);
      *(f32x4*)(src + k) = (f32x4){v[i][0] * rstd * gv[0], v[i][1] * rstd * gv[1], v[i][2] * rstd * gv[2], v[i][3] * rstd * gv[3]};
    }
  }
}

constexpr int LDT = 32;
constexpr int BUFSZ = 384 * LDT;
template <bool G0, bool G1, bool AKM, bool ROWSS>
DI void kloop(f32x16 (&acc)[2][4], const u16* __restrict__ A, int lda, int K, const u16* __restrict__ Bg0, const u16* __restrict__ Bg1, int ldb,
              u16* As, u16* Bs, float& ss0, float& ss1) {
  const int tid = otid(), lane = tid & 63, wave = tid >> 6, wm = wave >> 1, wn = wave & 1, r32 = lane & 31, hi = lane >> 5;
  u32x4 ra[2], rb0[2], rb1[2];
  const int lrow = tid >> 2, lkc = tid & 3;
  const int tk = tid >> 4, tmc = tid & 15;
#define GLOAD(k0)                                                                                              \
  do {                                                                                                         \
    if (!AKM) { _Pragma("unroll") for (int i = 0; i < 2; ++i) ra[i] = *(const u32x4*)(A + (long)(lrow + 64 * i) * lda + (k0) + lkc * 8); } \
    else      { _Pragma("unroll") for (int i = 0; i < 2; ++i) ra[i] = *(const u32x4*)(A + (long)((k0) + tk + 16 * i) * lda + tmc * 8); }  \
    if (G0) { _Pragma("unroll") for (int i = 0; i < 2; ++i) rb0[i] = *(const u32x4*)(Bg0 + (long)(lrow + 64 * i) * ldb + (k0) + lkc * 8); } \
    if (G1) { _Pragma("unroll") for (int i = 0; i < 2; ++i) rb1[i] = *(const u32x4*)(Bg1 + (long)(lrow + 64 * i) * ldb + (k0) + lkc * 8); } \
  } while (0)
#define SWZ(row, c) ((row) * LDT + (((c) ^ (((row) >> 2) & 3)) << 3))
#define LSTORE(AsD, BsD)                                                                                       \
  do {                                                                                                         \
    if (!AKM) {                                                                                                \
      _Pragma("unroll") for (int i = 0; i < 2; ++i) *(u32x4*)((AsD) + SWZ(lrow + 64 * i, lkc)) = ra[i]; \
      if (ROWSS) {                                                                                             \
        _Pragma("unroll") for (int e = 0; e < 4; ++e) {                                                        \
          float a0 = __uint_as_float(ra[0][e] << 16), a1 = __uint_as_float(ra[0][e] & 0xffff0000u);           \
          float c0 = __uint_as_float(ra[1][e] << 16), c1 = __uint_as_float(ra[1][e] & 0xffff0000u);           \
          ss0 += a0 * a0 + a1 * a1; ss1 += c0 * c0 + c1 * c1;                                                  \
        }                                                                                                      \
      }                                                                                                        \
    } else {                                                                                                   \
      _Pragma("unroll") for (int i = 0; i < 2; ++i) {                                                          \
        _Pragma("unroll") for (int e = 0; e < 8; ++e) (AsD)[SWZ(tmc * 8 + e, (tk + 16 * i) >> 3) + ((tk + 16 * i) & 7)] = (u16)(ra[i][e >> 1] >> (16 * (e & 1))); \
      }                                                                                                        \
    }                                                                                                          \
    if (G0) { _Pragma("unroll") for (int i = 0; i < 2; ++i) *(u32x4*)((BsD) + SWZ(lrow + 64 * i, lkc)) = rb0[i]; }       \
    if (G1) { _Pragma("unroll") for (int i = 0; i < 2; ++i) *(u32x4*)((BsD) + SWZ(128 + lrow + 64 * i, lkc)) = rb1[i]; } \
  } while (0)
  GLOAD(0);
  __syncthreads();
  LSTORE(As, Bs);
  if (32 < K) GLOAD(32);
  __syncthreads();
#pragma unroll 2
  for (int k0 = 0; k0 < K; k0 += 32) {
    const int cur = (k0 >> 5) & 1;
    const u16* Ac = As + cur * BUFSZ; const u16* Bc = Bs + cur * BUFSZ;
    if (k0 + 32 < K) { u16* An = As + (cur ^ 1) * BUFSZ; u16* Bn = Bs + (cur ^ 1) * BUFSZ; LSTORE(An, Bn); }
    if (k0 + 64 < K) GLOAD(k0 + 64);
#pragma unroll
    for (int ks = 0; ks < 2; ++ks) {
      bf16x8 af[2], bfr[4];
#pragma unroll
      for (int i = 0; i < 2; ++i) af[i] = *(const bf16x8*)(Ac + SWZ(wm * 64 + i * 32 + r32, ks * 2 + hi));
      if (G0) {
#pragma unroll
        for (int j = 0; j < 2; ++j) bfr[j] = *(const bf16x8*)(Bc + SWZ(wn * 64 + j * 32 + r32, ks * 2 + hi));
      }
      if (G1) {
#pragma unroll
        for (int j = 0; j < 2; ++j) bfr[2 + j] = *(const bf16x8*)(Bc + SWZ(128 + wn * 64 + j * 32 + r32, ks * 2 + hi));
      }
#pragma unroll
      for (int i = 0; i < 2; ++i) {
        if (G0) { acc[i][0] = MFMA32(af[i], bfr[0], acc[i][0]); acc[i][1] = MFMA32(af[i], bfr[1], acc[i][1]); }
        if (G1) { acc[i][2] = MFMA32(af[i], bfr[2], acc[i][2]); acc[i][3] = MFMA32(af[i], bfr[3], acc[i][3]); }
      }
    }
    __syncthreads();
  }
#undef LSTORE
#undef SWZ
#undef GLOAD
}

#define SWZ(row, c) ((row) * LDT + (((c) ^ (((row) >> 2) & 3)) << 3))
DI void glds16(const u16* g, u16* l) { __builtin_amdgcn_global_load_lds((const unsigned*)g, (unsigned*)l, 16, 0, 0); }
template <bool G0, bool G1, bool ROWSS = false>
DI void kloop_dma(f32x16 (&acc)[2][4], const u16* __restrict__ A, int lda, int K, const u16* __restrict__ Bg0, const u16* __restrict__ Bg1, int ldb, u16* L,
                  float* ssp0 = nullptr, float* ssp1 = nullptr) {
  const int tid = otid(), lane = tid & 63, wave = tid >> 6, wm = wave >> 1, wn = wave & 1, r32 = lane & 31, hi = lane >> 5;
  const int row0 = 16 * wave + (lane >> 2), lc = (lane & 3) ^ ((row0 >> 2) & 3);
  const u16* ga0 = A + (long)row0 * lda + lc * 8; const u16* ga1 = ga0 + (long)64 * lda;
  const u16* gb00 = Bg0 + (long)row0 * ldb + lc * 8; const u16* gb01 = gb00 + (long)64 * ldb;
  const u16* gb10 = Bg1 + (long)row0 * ldb + lc * 8; const u16* gb11 = gb10 + (long)64 * ldb;
  constexpr int NL = 2 + (G0 ? 2 : 0) + (G1 ? 2 : 0);
#define ISSUE(kt, bsel)                                                                              \
  do {                                                                                               \
    u16* Lb = L + (bsel) * BUFSZ; const int ko = (kt) * 32;                                          \
    glds16(ga0 + ko, Lb + wave * 512); glds16(ga1 + ko, Lb + (wave + 4) * 512);                      \
    if (G0) { glds16(gb00 + ko, Lb + 4096 + wave * 512); glds16(gb01 + ko, Lb + 4096 + (wave + 4) * 512); } \
    if (G1) { glds16(gb10 + ko, Lb + 8192 + wave * 512); glds16(gb11 + ko, Lb + 8192 + (wave + 4) * 512); } \
  } while (0)
  asm volatile("s_waitcnt vmcnt(0)" ::: "memory");
  __syncthreads();
  const int nk = K >> 5;
  ISSUE(0, 0);
  if (nk > 1) ISSUE(1, 1);
  auto kstep = [&](int k, auto bufc) __attribute__((always_inline)) {
    constexpr int BUF = decltype(bufc)::value;
    if (k + 1 < nk) asm volatile("s_waitcnt vmcnt(%0)" ::"n"(NL) : "memory"); else asm volatile("s_waitcnt vmcnt(0)" ::: "memory");
    asm volatile("s_waitcnt lgkmcnt(0)" ::: "memory");
    __builtin_amdgcn_s_barrier();
    asm volatile("" ::: "memory");
    const u16* Ac = L + BUF * BUFSZ; const u16* Bc = Ac + 128 * LDT;
    if (ROWSS) {
#pragma unroll
      for (int i = 0; i < 2; ++i) {
        const u32x4 c = *(const u32x4*)(Ac + SWZ((tid >> 2) + 64 * i, tid & 3));
        float sacc = 0.f;
#pragma unroll
        for (int e = 0; e < 4; ++e) { const float a0 = __uint_as_float(c[e] << 16), a1 = __uint_as_float(c[e] & 0xffff0000u); sacc += a0 * a0 + a1 * a1; }
        if (i == 0) *ssp0 += sacc; else *ssp1 += sacc;
      }
    }
#pragma unroll
    for (int ks = 0; ks < 2; ++ks) {
      bf16x8 af[2], bfr[4];
#pragma unroll
      for (int i = 0; i < 2; ++i) af[i] = *(const bf16x8*)(Ac + SWZ(wm * 64 + i * 32 + r32, ks * 2 + hi));
      if (G0) {
#pragma unroll
        for (int j = 0; j < 2; ++j) bfr[j] = *(const bf16x8*)(Bc + SWZ(wn * 64 + j * 32 + r32, ks * 2 + hi));
      }
      if (G1) {
#pragma unroll
        for (int j = 0; j < 2; ++j) bfr[2 + j] = *(const bf16x8*)(Bc + SWZ(128 + wn * 64 + j * 32 + r32, ks * 2 + hi));
      }
      if (ks == 1 && k + 2 < nk) { ISSUE(k + 2, (BUF + 2) % 3); }
      __builtin_amdgcn_s_setprio(1);
#pragma unroll
      for (int i = 0; i < 2; ++i) {
        if (G0) { acc[i][0] = MFMA32(af[i], bfr[0], acc[i][0]); acc[i][1] = MFMA32(af[i], bfr[1], acc[i][1]); }
        if (G1) { acc[i][2] = MFMA32(af[i], bfr[2], acc[i][2]); acc[i][3] = MFMA32(af[i], bfr[3], acc[i][3]); }
      }
      __builtin_amdgcn_s_setprio(0);
    }
  };
  int k3 = 0;
#pragma unroll 1
  for (; k3 + 3 <= nk; k3 += 3) {
    kstep(k3, std::integral_constant<int, 0>{}); kstep(k3 + 1, std::integral_constant<int, 1>{}); kstep(k3 + 2, std::integral_constant<int, 2>{});
  }
  if (k3 < nk) { kstep(k3, std::integral_constant<int, 0>{}); if (k3 + 1 < nk) kstep(k3 + 1, std::integral_constant<int, 1>{}); }
#undef ISSUE
}
#undef SWZ

DI float rope_apply(float v, int r32, int t, const float* rc) {
  const float partner = __shfl_xor(v, 16);
  const float cs = rc[t * 16 + (r32 & 15)], sn = rc[4096 * 16 + t * 16 + (r32 & 15)];
  return r32 < 16 ? v * cs - partner * sn : partner * sn + v * cs;
}

enum { EPI_UIN = 0, EPI_QUP, EPI_KVUP, EPI_G1, EPI_G2, EPI_RES, EPI_FFNIN };

template <int EPI>
DI void gemm_tile(const Params& p, int layer, int mt, int nt, char* smem, int resid_which, int ksl = -1) {
  u16* As = (u16*)smem; u16* Bs = As + 128 * LDT; float* rs = (float*)(As + 3 * BUFSZ);
  const int tid = otid(), lane = tid & 63, wave = tid >> 6, wm = wave >> 1, wn = wave & 1, r32 = lane & 31, hi = lane >> 5;
  const int m0 = mt * 128;
  const bool lat = m0 < RL;
  const int b = lat ? (m0 >> 12) : 8;
  const u16* Wt = (const u16*)(p.ws + OFF_WT);
  f32x16 acc[2][4];
#pragma unroll
  for (int i = 0; i < 2; ++i)
#pragma unroll
    for (int j = 0; j < 4; ++j)
#pragma unroll
      for (int r = 0; r < 16; ++r) acc[i][j][r] = 0.f;
  float ss0 = 0.f, ss1 = 0.f;
  const float* mod = (const float*)(p.ws + OFF_MOD) + ((long)layer * 9 + b) * 6144;
  const float* rc = (const float*)(p.ws + OFF_ROPE);

  if (EPI == EPI_UIN) {
    const u16* A = (const u16*)(p.ws + OFF_A) + (long)m0 * 1024;
    const u16* B0 = Wt + WIN_O + (long)(nt * 256) * 1024;
    kloop_dma<true, true>(acc, A, 1024, 1024, B0, B0 + 128 * 1024, 1024, As);
    u16* uT = (u16*)(p.ws + OFF_UT); u16* cq = (u16*)(p.ws + OFF_CQ); u16* ckv = (u16*)(p.ws + OFF_CKV); u16* kr = (u16*)(p.ws + OFF_KR);
#pragma unroll
    for (int j = 0; j < 4; ++j) {
      const int cb = nt * 256 + (j >> 1) * 128 + wn * 64 + (j & 1) * 32;
      const int col = cb + r32;
#pragma unroll
      for (int i = 0; i < 2; ++i) {
        const int mb = m0 + wm * 64 + i * 32;
        if (cb < 1536) {
#pragma unroll
          for (int g = 0; g < 4; ++g) {
            const u32x2 v = {pack2(acc[i][j][4 * g], acc[i][j][4 * g + 1]), pack2(acc[i][j][4 * g + 2], acc[i][j][4 * g + 3])};
            *(u32x2*)(uT + (long)col * MT + mb + 8 * g + 4 * hi) = v;
          }
        } else if (cb < 1920) {
          float v[16];
#pragma unroll
          for (int r = 0; r < 16; ++r) v[r] = acc[i][j][r];
          store_tile_bf16(cq + (long)mb * QL + (cb - 1536), QL, v, r32, hi);
        } else if (cb < 2176) {
          float v[16];
#pragma unroll
          for (int r = 0; r < 16; ++r) v[r] = acc[i][j][r];
          store_tile_bf16(ckv + (long)mb * KVL + (cb - 1920), KVL, v, r32, hi);
        } else if (cb < 2208) {
          float v[16];
#pragma unroll
          for (int r = 0; r < 16; ++r) {
            v[r] = acc[i][j][r];
            if (lat) v[r] = rope_apply(v[r], r32, (mb + crow(r, hi)) & 4095, rc);
          }
          store_tile_bf16(kr + (long)mb * 32, 32, v, r32, hi);
        } else if (cb < INC) {
          const int gc = col - OFFG;
          const float gbv = p.in[9][layer * 2048 + gc];
          unsigned char* g8 = (unsigned char*)(p.ws + OFF_G8) + (long)gc * MT + mb + 4 * hi;
#pragma unroll
          for (int g = 0; g < 4; ++g) {
            unsigned wv = 0;
#pragma unroll
            for (int e = 0; e < 4; ++e) wv |= (unsigned)(sigmoidf_(acc[i][j][4 * g + e] + gbv) * 255.f + 0.5f) << (8 * e);
            *(unsigned*)(g8 + 8 * g) = wv;
          }
        }
      }
    }
  } else if (EPI == EPI_QUP) {
    const u16* A = (const u16*)(p.ws + OFF_CQ) + (long)m0 * QL;
    const u16* B0 = Wt + WUQ_O + (long)(nt * 256) * QL;
    kloop_dma<true, true, true>(acc, A, QL, QL, B0, B0 + 128 * QL, QL, As, &ss0, &ss1);
    ss0 += __shfl_xor(ss0, 1); ss0 += __shfl_xor(ss0, 2); ss1 += __shfl_xor(ss1, 1); ss1 += __shfl_xor(ss1, 2);
    if ((tid & 3) == 0) { rs[tid >> 2] = rsqrtf(ss0 * (1.f / QL) + EPS); rs[64 + (tid >> 2)] = rsqrtf(ss1 * (1.f / QL) + EPS); }
    __syncthreads();
    u16* q = (u16*)(p.ws + OFF_QN);
#pragma unroll
    for (int j = 0; j < 4; ++j) {
      const int cb = nt * 256 + (j >> 1) * 128 + wn * 64 + (j & 1) * 32;
      const bool isrope = ((cb >> 5) % 3) == 2;
#pragma unroll
      for (int i = 0; i < 2; ++i) {
        const int ml = wm * 64 + i * 32;
        float v[16];
#pragma unroll
        for (int r = 0; r < 16; ++r) {
          const int mrow = ml + crow(r, hi), m = m0 + mrow;
          v[r] = acc[i][j][r] * rs[mrow];
          if (isrope && lat) v[r] = rope_apply(v[r], r32, m & 4095, rc);
        }
        store_tile_bf16(q + (long)(m0 + ml) * 1536 + cb, 1536, v, r32, hi);
      }
    }
    __syncthreads();
  } else if (EPI == EPI_KVUP) {
    const u16* A = (const u16*)(p.ws + OFF_CKV) + (long)m0 * KVL;
    const u16* B0 = Wt + WUKV_O + (long)(nt * 256) * KVL;
    kloop_dma<true, true, true>(acc, A, KVL, KVL, B0, B0 + 128 * KVL, KVL, As, &ss0, &ss1);
    ss0 += __shfl_xor(ss0, 1); ss0 += __shfl_xor(ss0, 2); ss1 += __shfl_xor(ss1, 1); ss1 += __shfl_xor(ss1, 2);
    if ((tid & 3) == 0) { rs[tid >> 2] = rsqrtf(ss0 * (1.f / KVL) + EPS); rs[64 + (tid >> 2)] = rsqrtf(ss1 * (1.f / KVL) + EPS); }
    __syncthreads();
    u16* kn = (u16*)(p.ws + OFF_KN); u16* vT = (u16*)(p.ws + OFF_VT);
    const int bb = lat ? b : ((m0 - RL) >> 8);
    const int key0 = lat ? (m0 & 4095) : (4096 + ((m0 - RL) & 255));
#pragma unroll
    for (int j = 0; j < 4; ++j) {
      const int cb = nt * 256 + (j >> 1) * 128 + wn * 64 + (j & 1) * 32;
      const int h = cb >> 7, sub = (cb >> 5) & 3;
#pragma unroll
      for (int i = 0; i < 2; ++i) {
        const int ml = wm * 64 + i * 32;
        if (sub < 2) {
          float v[16];
#pragma unroll
          for (int r = 0; r < 16; ++r) v[r] = acc[i][j][r] * rs[ml + crow(r, hi)];
          store_tile_bf16(kn + (long)(m0 + ml) * 1024 + h * 64 + sub * 32, 1024, v, r32, hi);
        } else {
          const int dim = (sub - 2) * 32 + r32;
          u16* dst = vT + ((long)(bb * NH + h) * 64 + dim) * KEYS + key0 + ml;
#pragma unroll
          for (int g = 0; g < 4; ++g) {
            const int mr = 8 * g + 4 * hi;
            const u32x2 v = {pack2(acc[i][j][4 * g] * rs[ml + mr], acc[i][j][4 * g + 1] * rs[ml + mr + 1]),
                             pack2(acc[i][j][4 * g + 2] * rs[ml + mr + 2], acc[i][j][4 * g + 3] * rs[ml + mr + 3])};
            *(u32x2*)(dst + mr) = v;
          }
        }
      }
    }
    __syncthreads();
  } else if (EPI == EPI_G1 || EPI == EPI_G2) {
    const int n0 = nt * 128;
    {
      const u16* A1 = (const u16*)(p.ws + OFF_UT) + (long)1024 * MT + m0;
      const u16* Bp = Wt + WHY_O + (long)n0 * 512;
      kloop<true, false, true, false>(acc, A1, MT, 512, Bp, Bp, 512, As, Bs, ss0, ss1);
    }
    {
      const u16* A1 = (const u16*)(p.ws + OFF_UT) + (long)m0 * 1024;
      const u16* Bp = Wt + WMLA_O + (long)n0 * 1024;
      kloop_dma<false, true>(acc, A1, 1024, 1024, Bp, Bp, 1024, As);
    }
    const unsigned char* g8 = (const unsigned char*)(p.ws + OFF_G8);
    u16* mo = (u16*)(p.ws + OFF_VT);
#pragma unroll
    for (int j = 0; j < 2; ++j) {
      const int col = n0 + wn * 64 + j * 32 + r32;
#pragma unroll
      for (int i = 0; i < 2; ++i) {
        const int mb = m0 + wm * 64 + i * 32 + 4 * hi;
        float v[16];
#pragma unroll
        for (int g = 0; g < 4; ++g) {
          const unsigned gh = *(const unsigned*)(g8 + (long)col * MT + mb + 8 * g);
          const unsigned ga = *(const unsigned*)(g8 + (long)(1024 + col) * MT + mb + 8 * g);
#pragma unroll
          for (int e = 0; e < 4; ++e) {
            const float fh = (float)((gh >> (8 * e)) & 255u) * (1.f / 255.f), fa = (float)((ga >> (8 * e)) & 255u) * (1.f / 255.f);
            v[4 * g + e] = fh * acc[i][j][4 * g + e] + fa * acc[i][2 + j][4 * g + e];
          }
        }
        store_tile_bf16(mo + (long)(m0 + wm * 64 + i * 32) * 1024 + n0 + wn * 64 + j * 32, 1024, v, r32, hi);
      }
    }
  } else if (EPI == EPI_RES) {
    const int n0 = nt * 256;
    if (resid_which == 0) {
      const int Ks = ksl < 0 ? 1024 : 128, k0 = ksl < 0 ? 0 : ksl * 128;
      const u16* A = (const u16*)(p.ws + OFF_VT) + (long)m0 * 1024 + k0;
      const u16* B0 = Wt + WOUT_O + (long)n0 * 1024 + k0;
      kloop_dma<true, true>(acc, A, 1024, Ks, B0, B0 + 128 * 1024, 1024, As);
    } else {
      const int Ks = ksl < 0 ? DFF : DFF / 8, k0 = ksl < 0 ? 0 : ksl * (DFF / 8);
      const u16* A = (const u16*)(p.ws + OFF_KN) + (long)m0 * DFF + k0;
      const u16* B0 = Wt + WFOUT_O + (long)n0 * DFF + k0;
      kloop_dma<true, true>(acc, A, DFF, Ks, B0, B0 + 128 * DFF, DFF, As);
    }
    const float* gate = mod + (resid_which ? 5 : 2) * 1024;
    const bool first = (layer == 0 && resid_which == 0);
    const float* hold; float* hnew; long rbase;
    if (lat) { hold = first ? p.in[0] : p.out; hnew = p.out; rbase = m0; }
    else { hold = (const float*)(p.ws + OFF_HC); hnew = (float*)(p.ws + OFF_HC); rbase = m0 - RL; }
    const bool odd = r32 & 1;
#pragma unroll
    for (int j = 0; j < 4; ++j) {
      const int col = n0 + (j >> 1) * 128 + wn * 64 + (j & 1) * 32 + r32;
      const float gv = gate[col];
#pragma unroll
      for (int i = 0; i < 2; ++i) {
        if (ksl < 0) {
#pragma unroll
          for (int rp = 0; rp < 8; ++rp) {
            const float sa = gv * acc[i][j][2 * rp], sb = gv * acc[i][j][2 * rp + 1];
            const float recv = dpp_swap1(odd ? sa : sb);
            const int row = ((2 * rp) & 3) + 8 * ((2 * rp) >> 2) + 4 * hi + (odd ? 1 : 0);
            const long idx = (rbase + wm * 64 + i * 32 + row) * 1024 + (col & ~1);
            const f32x2 h = *(const f32x2*)(hold + idx);
            *(f32x2*)(hnew + idx) = odd ? (f32x2){h[0] + recv, h[1] + sb} : (f32x2){h[0] + sa, h[1] + recv};
          }
        } else {
#pragma unroll
          for (int r = 0; r < 16; ++r) {
            const long idx = (rbase + wm * 64 + i * 32 + crow(r, hi)) * 1024 + col;
            atomicAdd(hnew + idx, gv * acc[i][j][r]);
          }
        }
      }
    }
  } else if (EPI == EPI_FFNIN) {
    const int n0 = nt * 128;
    const u16* A = (const u16*)(p.ws + OFF_A) + (long)m0 * 1024;
    const u16* B0 = Wt + WFIN_O + (long)n0 * 1024;
    kloop_dma<true, true>(acc, A, 1024, 1024, B0, B0 + (long)DFF * 1024, 1024, As);
    u16* act = (u16*)(p.ws + OFF_KN);
#pragma unroll
    for (int j = 0; j < 2; ++j) {
#pragma unroll
      for (int i = 0; i < 2; ++i) {
        float v[16];
#pragma unroll
        for (int r = 0; r < 16; ++r) { const float gte = acc[i][j][r], u = acc[i][2 + j][r]; v[r] = gte * sigmoidf_(gte) * u; }
        store_tile_bf16(act + (long)(m0 + wm * 64 + i * 32) * DFF + n0 + wn * 64 + j * 32, DFF, v, r32, hi);
      }
    }
  }
}

constexpr int KLD = 104, VLD = 72;
DI void attn_item(const Params& p, bool ctxq, int b, int h, int qb, char* smem) {
  constexpr int ABUF = 64 * KLD + 64 * VLD;
  u16* Ks0 = (u16*)smem; float* wsc = (float*)(Ks0 + 3 * ABUF);
  const int tid = otid(), lane = tid & 63, wave = tid >> 6, r32 = lane & 31, hi = lane >> 5;
  float* al = wsc + wave * 128;
  const u16* q = (const u16*)(p.ws + OFF_QN); const u16* kn = (const u16*)(p.ws + OFF_KN); const u16* kr = (const u16*)(p.ws + OFF_KR);
  const u16* vT = (const u16*)(p.ws + OFF_VT) + (long)(b * NH + h) * 64 * KEYS;
  u16* att = (u16*)(p.ws + OFF_UT);
  const long mq0 = ctxq ? (RL + b * 256) : ((long)b * 4096 + qb * 256);
  const int kt0 = ctxq ? 64 : 0, kt1 = 68;
  bf16x8 qf[2][6];
#pragma unroll
  for (int rb = 0; rb < 2; ++rb) {
    const u16* qp = q + (mq0 + wave * 64 + rb * 32 + r32) * 1536 + h * 96 + hi * 8;
#pragma unroll
    for (int d0 = 0; d0 < 6; ++d0) qf[rb][d0] = *(const bf16x8*)(qp + d0 * 16);
  }
  f32x16 o[2][2];
#pragma unroll
  for (int rb = 0; rb < 2; ++rb)
#pragma unroll
    for (int d = 0; d < 2; ++d)
#pragma unroll
      for (int r = 0; r < 16; ++r) o[rb][d][r] = 0.f;
  float m_run[2] = {-1e30f, -1e30f}, l_run[2] = {0.f, 0.f};
  constexpr float C = 0.10206207261596577f * 1.4426950408889634f;
  u16* dump = (u16*)(wsc + 512);
  const u16* gk[4]; int kpitch[4]; const u16* gv[3];
  const long mk00 = ctxq ? (RL + b * 256) : ((long)b * 4096);
#pragma unroll
  for (int i = 0; i < 4; ++i) {
    const int slot = wave + 4 * i, c = slot * 64 + lane;
    const bool real = slot < 13;
    int row = c / 13, part = c - row * 13;
    if (!real) { row = 0; part = 0; }
    if (part == 12) part = 0;
    if (part < 8) { gk[i] = kn + (mk00 + row) * 1024 + h * 64 + part * 8; kpitch[i] = 1024; }
    else { gk[i] = kr + (mk00 + row) * 32 + (part - 8) * 8; kpitch[i] = 32; }
  }
#pragma unroll
  for (int i = 0; i < 3; ++i) {
    const int slot = wave + 4 * i, c = slot * 64 + lane;
    const bool real = slot < 9;
    int dim = c / 9, part = c - dim * 9;
    if (!real) { dim = 0; part = 0; }
    if (part == 8) part = 0;
    gv[i] = vT + (long)dim * KEYS + kt0 * 64 + part * 8;
  }
  const int ctxjump = ctxq ? 0 : (RL + b * 256) - (b * 4096 + 4096);
#define AISSUE(j, bsel)                                                                                    \
  do {                                                                                                     \
    const int rowofs = 64 * (j) + ((kt0 + (j)) >= 64 ? ctxjump : 0);                                       \
    u16* KsD = Ks0 + (bsel) * ABUF; u16* VsD = KsD + 64 * KLD;                                             \
    _Pragma("unroll") for (int i = 0; i < 4; ++i) {                                                        \
      const int slot = wave + 4 * i;                                                                       \
      glds16(gk[i] + (long)rowofs * kpitch[i], slot < 13 ? KsD + slot * 512 : dump);                       \
    }                                                                                                      \
    _Pragma("unroll") for (int i = 0; i < 3; ++i) {                                                        \
      const int slot = wave + 4 * i;                                                                       \
      glds16(gv[i] + 64 * (j), slot < 9 ? VsD + slot * 512 : dump);                                        \
    }                                                                                                      \
  } while (0)
  const int n = kt1 - kt0;
  asm volatile("s_waitcnt vmcnt(0)" ::: "memory");
  __syncthreads();
  AISSUE(0, 0);
  AISSUE(1, 1);
  int buf = 0;
#pragma unroll 1
  for (int j = 0; j < n; ++j) {
    if (j + 1 < n) asm volatile("s_waitcnt vmcnt(7)" ::: "memory"); else asm volatile("s_waitcnt vmcnt(0)" ::: "memory");
    asm volatile("s_waitcnt lgkmcnt(0)" ::: "memory");
    __builtin_amdgcn_s_barrier();
    asm volatile("" ::: "memory");
    if (j + 2 < n) { const int nb = buf == 0 ? 2 : buf - 1; AISSUE(j + 2, nb); }
    const u16* Ks = Ks0 + buf * ABUF; const u16* Vs = Ks + 64 * KLD;
    buf = buf == 2 ? 0 : buf + 1;
    f32x16 pp[2][2];
#pragma unroll
    for (int rb = 0; rb < 2; ++rb)
#pragma unroll
      for (int kb = 0; kb < 2; ++kb)
#pragma unroll
        for (int r = 0; r < 16; ++r) pp[rb][kb][r] = 0.f;
#pragma unroll
    for (int d0 = 0; d0 < 6; ++d0) {
#pragma unroll
      for (int kb = 0; kb < 2; ++kb) {
        const bf16x8 kf = *(const bf16x8*)(Ks + (kb * 32 + r32) * KLD + d0 * 16 + hi * 8);
        pp[0][kb] = MFMA32(kf, qf[0][d0], pp[0][kb]);
        pp[1][kb] = MFMA32(kf, qf[1][d0], pp[1][kb]);
      }
    }
    constexpr float THRS = 8.f / 0.10206207261596577f;
    float pmx[2];
#pragma unroll
    for (int rb = 0; rb < 2; ++rb) {
      float pmax = pp[rb][0][0];
#pragma unroll
      for (int r = 1; r < 16; ++r) pmax = fmaxf(pmax, pp[rb][0][r]);
#pragma unroll
      for (int r = 0; r < 16; ++r) pmax = fmaxf(pmax, pp[rb][1][r]);
      pmx[rb] = fmaxf(pmax, __shfl_xor(pmax, 32));
    }
    const bool keep = __all((pmx[0] - m_run[0] <= THRS) && (pmx[1] - m_run[1] <= THRS));
    float alpha[2] = {1.f, 1.f};
    if (!keep) {
#pragma unroll
      for (int rb = 0; rb < 2; ++rb) {
        const float m_new = fmaxf(m_run[rb], pmx[rb]);
        alpha[rb] = __builtin_amdgcn_exp2f((m_run[rb] - m_new) * C);
        m_run[rb] = m_new;
      }
    }
#pragma unroll
    for (int rb = 0; rb < 2; ++rb) {
      const float mc = -m_run[rb] * C;
      const f32x2 C2 = {C, C}, mc2 = {mc, mc};
      f32x2 ps2 = {0.f, 0.f};
#pragma unroll
      for (int kb = 0; kb < 2; ++kb)
#pragma unroll
        for (int r = 0; r < 16; r += 2) {
          const f32x2 t = __builtin_elementwise_fma((f32x2){pp[rb][kb][r], pp[rb][kb][r + 1]}, C2, mc2);
          const f32x2 e = {__builtin_amdgcn_exp2f(t[0]), __builtin_amdgcn_exp2f(t[1])};
          pp[rb][kb][r] = e[0]; pp[rb][kb][r + 1] = e[1];
          ps2 += e;
        }
      float psum = ps2[0] + ps2[1];
      psum += __shfl_xor(psum, 32);
      l_run[rb] = l_run[rb] * alpha[rb] + psum;
    }
    if (!keep) {
      if (hi == 0) { al[r32] = alpha[0]; al[32 + r32] = alpha[1]; }
      asm volatile("s_waitcnt lgkmcnt(0)" ::: "memory");
#pragma unroll
      for (int rb = 0; rb < 2; ++rb)
#pragma unroll
        for (int r = 0; r < 16; ++r) { const float a = al[rb * 32 + crow(r, hi)]; o[rb][0][r] *= a; o[rb][1][r] *= a; }
    }
#pragma unroll
    for (int s = 0; s < 4; ++s) {
      const int kb = s >> 1, rbs = (s & 1) * 8;
      bf16x8 pa[2];
#pragma unroll
      for (int rb = 0; rb < 2; ++rb) {
        const u32x4 pw = {pack2(pp[rb][kb][rbs], pp[rb][kb][rbs + 1]), pack2(pp[rb][kb][rbs + 2], pp[rb][kb][rbs + 3]),
                          pack2(pp[rb][kb][rbs + 4], pp[rb][kb][rbs + 5]), pack2(pp[rb][kb][rbs + 6], pp[rb][kb][rbs + 7])};
        pa[rb] = __builtin_bit_cast(bf16x8, pw);
      }
#pragma unroll
      for (int d = 0; d < 2; ++d) {
        const u16* vp = Vs + (d * 32 + r32) * VLD + 16 * s + 4 * hi;
        const u32x2 v0 = *(const u32x2*)vp, v1 = *(const u32x2*)(vp + 8);
        const u32x4 vw = {v0[0], v0[1], v1[0], v1[1]};
        const bf16x8 vf = __builtin_bit_cast(bf16x8, vw);
        o[0][d] = MFMA32(pa[0], vf, o[0][d]);
        o[1][d] = MFMA32(pa[1], vf, o[1][d]);
      }
    }
  }
#undef AISSUE
  asm volatile("s_waitcnt lgkmcnt(0)" ::: "memory");
  if (hi == 0) { al[64 + r32] = l_run[0]; al[96 + r32] = l_run[1]; }
  asm volatile("s_waitcnt lgkmcnt(0)" ::: "memory");
#pragma unroll
  for (int rb = 0; rb < 2; ++rb) {
    float il[16];
#pragma unroll
    for (int r = 0; r < 16; ++r) il[r] = __builtin_amdgcn_rcpf(al[64 + rb * 32 + crow(r, hi)]);
#pragma unroll
    for (int d = 0; d < 2; ++d) {
      float v[16];
#pragma unroll
      for (int r = 0; r < 16; ++r) v[r] = o[rb][d][r] * il[r];
      store_tile_bf16(att + (mq0 + wave * 64 + rb * 32) * 1024 + h * 64 + d * 32, 1024, v, r32, hi);
    }
  }
  __syncthreads();
}

constexpr float HY_MIN_DECAY = -3.0701134573253943f, HY_MAX_DECAY = -15.350567286626972f;
DI int phys(int i) { return i + (i >> 4); }
DI unsigned packh2(float a, float b) { f32x2 v = {a, b}; f16x2_t h = __builtin_convertvector(v, f16x2_t); return __builtin_bit_cast(unsigned, h); }
DI f32x2 unpackh2(unsigned u) { f16x2_t h = __builtin_bit_cast(f16x2_t, u); return __builtin_convertvector(h, f32x2); }
DI float opaque(float x) { asm volatile("" : "+v"(x)); return x; }
DI constexpr int brev4(int p) { return ((p & 1) << 3) | ((p & 2) << 1) | ((p & 4) >> 1) | ((p & 8) >> 3); }

DI f32x2 cmul(f32x2 a, f32x2 w) { return (f32x2){a[0] * w[0] - a[1] * w[1], a[0] * w[1] + a[1] * w[0]}; }
template <bool INV, int S>
DI void dft16_stage(f32x2 (&a)[16]) {
  constexpr float C16[8] = {1.f, 0.92387953251128674f, 0.70710678118654752f, 0.38268343236508977f, 0.f, -0.38268343236508977f, -0.70710678118654752f, -0.92387953251128674f};
  constexpr float S16[8] = {0.f, 0.38268343236508977f, 0.70710678118654752f, 0.92387953251128674f, 1.f, 0.92387953251128674f, 0.70710678118654752f, 0.38268343236508977f};
#pragma unroll
  for (int i = 0; i < 16; ++i) {
    if ((i & S) == 0) {
      const int j = i & (S - 1), tw = j * (8 / S);
      const f32x2 u = a[i], v = a[i + S];
      a[i] = u + v;
      const f32x2 d = u - v;
      if (tw == 0) a[i + S] = d;
      else if (tw == 4) a[i + S] = INV ? (f32x2){-d[1], d[0]} : (f32x2){d[1], -d[0]};
      else a[i + S] = cmul(d, (f32x2){C16[tw], INV ? S16[tw] : -S16[tw]});
    }
  }
}
template <bool INV>
DI void dft16(f32x2 (&a)[16]) { dft16_stage<INV, 8>(a); dft16_stage<INV, 4>(a); dft16_stage<INV, 2>(a); dft16_stage<INV, 1>(a); }

template <int S>
DI void idft16_dit_stage(f32x2 (&a)[16]) {
  constexpr float C16[8] = {1.f, 0.92387953251128674f, 0.70710678118654752f, 0.38268343236508977f, 0.f, -0.38268343236508977f, -0.70710678118654752f, -0.92387953251128674f};
  constexpr float S16[8] = {0.f, 0.38268343236508977f, 0.70710678118654752f, 0.92387953251128674f, 1.f, 0.92387953251128674f, 0.70710678118654752f, 0.38268343236508977f};
#pragma unroll
  for (int i = 0; i < 16; ++i) {
    if ((i & S) == 0) {
      const int j = i & (S - 1), tw = j * (8 / S);
      const f32x2 u = a[i];
      f32x2 v = a[i + S];
      if (tw == 4) v = (f32x2){-v[1], v[0]};
      else if (tw != 0) v = cmul(v, (f32x2){C16[tw], S16[tw]});
      a[i] = u + v; a[i + S] = u - v;
    }
  }
}
DI void idft16_dit(f32x2 (&a)[16]) { idft16_dit_stage<1>(a); idft16_dit_stage<2>(a); idft16_dit_stage<4>(a); idft16_dit_stage<8>(a); }

template <int NSUB, bool INV>
DI void fft_pass(f32x2* x) {
  constexpr int m = NSUB / 16;
  const int tid = otid();
  const int j = tid % m;
  f32x2 w[9];
  {
    const float fr = opaque((float)j / (float)NSUB);
    const float c1 = __builtin_amdgcn_cosf(fr), s1 = __builtin_amdgcn_sinf(fr);
    w[0] = (f32x2){1.f, 0.f}; w[1] = (f32x2){c1, INV ? s1 : -s1};
    w[2] = cmul(w[1], w[1]); w[3] = cmul(w[2], w[1]); w[4] = cmul(w[2], w[2]); w[5] = cmul(w[4], w[1]);
    w[6] = cmul(w[4], w[2]); w[7] = cmul(w[4], w[3]); w[8] = cmul(w[4], w[4]);
  }
#pragma unroll
  for (int gi = 0; gi < 2; ++gi) {
    const int g = tid + 256 * gi, b0 = (g / m) * NSUB;
    f32x2 a[16];
    if (!INV) {
#pragma unroll
      for (int q = 0; q < 16; ++q) a[q] = x[phys(b0 + j + q * m)];
      dft16<false>(a);
#pragma unroll
      for (int pp = 0; pp < 16; ++pp) {
        const int r = brev4(pp);
        const f32x2 t = r < 8 ? w[r] : cmul(w[r - 8], w[8]);
        x[phys(b0 + r * m + j)] = cmul(a[pp], t);
      }
    } else {
#pragma unroll
      for (int r = 0; r < 16; ++r) {
        const f32x2 t = r < 8 ? w[r] : cmul(w[r - 8], w[8]);
        a[r] = cmul(x[phys(b0 + r * m + j)], t);
      }
      dft16<true>(a);
#pragma unroll
      for (int pp = 0; pp < 16; ++pp) { const int q = brev4(pp); x[phys(b0 + j + q * m)] = a[pp]; }
    }
  }
}

DI float sconv(const u16* row, long seg, int i, int L, float w0, float w1, float w2, float bb) {
  const float um = i > 0 ? bf2f(row[seg + i - 1]) : 0.f, u0 = bf2f(row[seg + i]), up = i < L - 1 ? bf2f(row[seg + i + 1]) : 0.f;
  return w0 * um + w1 * u0 + w2 * up + bb;
}

DI void hyena_lat_item(const Params& p, int layer, int w, char* smem) {
  f32x2* x = (f32x2*)smem;
  float* sc = (float*)(smem + 8704 * 8);
  const int tid = otid();
  u16* uT = (u16*)(p.ws + OFF_UT);
  u16* vrow = uT + (long)(1024 + w) * MT;
  const float* h2 = (const float*)(p.ws + OFF_H2) + (long)layer * 4096 * 64;
  const float* w3 = p.in[16] + (long)layer * 64 * 2048;
  const float* cw = p.in[10] + layer * 3 * 1536, *cb = p.in[11] + layer * 1536;
  const float absd = -(HY_MIN_DECAY + (float)w * ((HY_MAX_DECAY - HY_MIN_DECAY) / 511.f));
  {
#pragma unroll 1
    for (int rsel = 0; rsel < 3; ++rsel) {
      const int ch = rsel * 512 + w;
      u16* row = uT + (long)ch * MT;
      const float w0 = cw[ch], w1 = cw[1536 + ch], w2 = cw[3072 + ch], bb = cb[ch];
#pragma unroll 1
      for (int g4 = 0; g4 < 1; ++g4) {
        u32x4 o0[8], o1[8];
        const int t16 = otid() * 16;
#pragma unroll
        for (int q = 0; q < 8; ++q) {
          const u16* seg = row + (long)q * 4096 + t16;
          const u32x4 r0 = *(const u32x4*)seg, r1 = *(const u32x4*)(seg + 8);
          const float hl = t16 > 0 ? bf2f(seg[-1]) : 0.f, hr = t16 < 4080 ? bf2f(seg[16]) : 0.f;
          float u[18];
          u[0] = hl; u[17] = hr;
#pragma unroll
          for (int e = 0; e < 4; ++e) {
            u[1 + 2 * e] = __uint_as_float(r0[e] << 16); u[2 + 2 * e] = __uint_as_float(r0[e] & 0xffff0000u);
            u[9 + 2 * e] = __uint_as_float(r1[e] << 16); u[10 + 2 * e] = __uint_as_float(r1[e] & 0xffff0000u);
          }
          float y[16];
#pragma unroll
          for (int e = 0; e < 16; ++e) y[e] = w0 * u[e] + w1 * u[e + 1] + w2 * u[e + 2] + bb;
          o0[q] = (u32x4){pack2(y[0], y[1]), pack2(y[2], y[3]), pack2(y[4], y[5]), pack2(y[6], y[7])};
          o1[q] = (u32x4){pack2(y[8], y[9]), pack2(y[10], y[11]), pack2(y[12], y[13]), pack2(y[14], y[15])};
        }
        asm volatile("s_waitcnt vmcnt(0)" ::: "memory");
        __syncthreads();
#pragma unroll
        for (int q = 0; q < 8; ++q) {
          u16* seg = row + (long)q * 4096 + t16;
          *(u32x4*)seg = o0[q]; *(u32x4*)(seg + 8) = o1[q];
        }
      }
    }
    __syncthreads();
  }
  unsigned Hp[2][16];
#pragma unroll 1
  for (int o = 0; o < 2; ++o) {
    const u16* grow = uT + (long)(o * 512 + w) * MT;
    const float bias = p.in[18][(layer * 2 + o) * 512 + w];
    __syncthreads();
    if (tid < 64) sc[16 + tid] = w3[tid * 2048 + o * 512 + w];
    else if (tid < 128) sc[80 + tid - 64] = w3[(tid - 64) * 2048 + 1024 + o * 512 + w];
    __syncthreads();
    float asum = 0.f;
#pragma unroll 4
    for (int k = 0; k < 16; ++k) {
      const int jj = otid() + 256 * k;
      const f32x4* hr = (const f32x4*)(h2 + (long)jj * 64);
      float df = 0.f, db = 0.f;
      int zoff = 0; asm volatile("" : "+v"(zoff));
      const f32x4* scf = (const f32x4*)(sc + 16 + zoff);
#pragma unroll
      for (int q4 = 0; q4 < 16; ++q4) {
        const f32x4 hv = hr[q4], wf = scf[q4], wb = scf[16 + q4];
        df += hv[0] * wf[0] + hv[1] * wf[1] + hv[2] * wf[2] + hv[3] * wf[3];
        db += hv[0] * wb[0] + hv[1] * wb[1] + hv[2] * wb[2] + hv[3] * wb[3];
      }
      const float win = __expf(-((float)jj * (1.f / 4095.f)) * absd);
      const float f = df * win, bk = db * win;
      asum += fabsf(f) + (jj > 0 ? fabsf(bk) : 0.f);
      x[phys(4096 + jj)] = (f32x2){f, bk};
    }
    asum = wave_sum(asum);
    if ((tid & 63) == 0) sc[tid >> 6] = asum;
    __syncthreads();
    const float norm = sc[0] + sc[1] + sc[2] + sc[3];
    {
      float a0[16], a1[16];
#pragma unroll
      for (int k = 0; k < 16; ++k) {
        const int i = otid() + 256 * k;
        a0[k] = x[phys(4096 + i)][0];
        a1[k] = i == 0 ? 0.f : x[phys(8192 - i)][1];
      }
      __syncthreads();
#pragma unroll
      for (int k = 0; k < 16; ++k) {
        const int i = otid() + 256 * k;
        const float fr = opaque((float)i * (1.f / 8192.f));
        const float c = __builtin_amdgcn_cosf(fr), s = __builtin_amdgcn_sinf(fr);
        const float d = a0[k] - a1[k];
        x[phys(i)] = (f32x2){a0[k] + a1[k], 0.f};
        x[phys(4096 + i)] = (f32x2){d * c, -d * s};
      }
    }
    __syncthreads();
    fft_pass<4096, false>(x); __syncthreads();
    fft_pass<256, false>(x); __syncthreads();
    {
      const float scale = 1.f / norm;
#pragma unroll
      for (int gi = 0; gi < 2; ++gi) {
        const int g = otid() + 256 * gi, b0 = g * 16;
        f32x2 a[16];
#pragma unroll
        for (int q = 0; q < 16; ++q) a[q] = x[b0 + q + g];
        dft16<false>(a);
#pragma unroll
        for (int q = 0; q < 16; ++q) Hp[gi][q] = packh2(a[q][0] * scale, a[q][1] * scale);
        __builtin_amdgcn_sched_barrier(0);
      }
    }
    __syncthreads();
#pragma unroll 1
    for (int pr = 0; pr < 4; ++pr) {
      const long s0 = (long)(2 * pr) * 4096, s1 = s0 + 4096;
      {
        const int tt = otid();
        const u16* pv0 = vrow + s0 + tt * 16; const u16* pv1 = vrow + s1 + tt * 16;
        const u32x4 a0 = *(const u32x4*)pv0, a1 = *(const u32x4*)(pv0 + 8), b0v = *(const u32x4*)pv1, b1v = *(const u32x4*)(pv1 + 8);
        const float fr = opaque((float)(tt * 16) * (1.f / 8192.f));
        f32x2 wq = {__builtin_amdgcn_cosf(fr), -__builtin_amdgcn_sinf(fr)};
        const f32x2 dw = {0.99999970588366f, -7.6699031874270e-4f};
        f32x2* xl = x + tt * 17; f32x2* xh = x + 4352 + tt * 17;
#pragma unroll
        for (int k = 0; k < 16; ++k) {
          const unsigned ua = k < 8 ? a0[k >> 1] : a1[(k - 8) >> 1], ub = k < 8 ? b0v[k >> 1] : b1v[(k - 8) >> 1];
          const float re = (k & 1) ? __uint_as_float(ua & 0xffff0000u) : __uint_as_float(ua << 16);
          const float im = (k & 1) ? __uint_as_float(ub & 0xffff0000u) : __uint_as_float(ub << 16);
          const f32x2 z = {re, im};
          xl[k] = z; xh[k] = cmul(z, wq);
          wq = cmul(wq, dw);
        }
      }
      __syncthreads();
      fft_pass<4096, false>(x); __syncthreads();
      fft_pass<256, false>(x); __syncthreads();
#pragma unroll
      for (int gi = 0; gi < 2; ++gi) {
        const int g = otid() + 256 * gi, b0 = g * 16;
        f32x2 a[16];
#pragma unroll
        for (int q = 0; q < 16; ++q) a[q] = x[b0 + q + g];
        dft16<false>(a);
#pragma unroll
        for (int pp = 0; pp < 16; ++pp) a[pp] = cmul(a[pp], unpackh2(Hp[gi][pp]));
        idft16_dit(a);
#pragma unroll
        for (int q = 0; q < 16; ++q) x[b0 + q + g] = a[q];
        __builtin_amdgcn_sched_barrier(0);
      }
      __syncthreads();
      fft_pass<256, true>(x); __syncthreads();
      fft_pass<4096, true>(x); __syncthreads();
      {
        const int tt = otid();
        u16* pv0 = vrow + s0 + tt * 16; u16* pv1 = vrow + s1 + tt * 16;
        const u16* pg0 = grow + s0 + tt * 16; const u16* pg1 = grow + s1 + tt * 16;
        const u32x4 a0 = *(const u32x4*)pv0, a1 = *(const u32x4*)(pv0 + 8), b0v = *(const u32x4*)pv1, b1v = *(const u32x4*)(pv1 + 8);
        const u32x4 c0 = *(const u32x4*)pg0, c1 = *(const u32x4*)(pg0 + 8), d0 = *(const u32x4*)pg1, d1 = *(const u32x4*)(pg1 + 8);
        const float fr = opaque((float)(tt * 16) * (1.f / 8192.f));
        f32x2 wq = {__builtin_amdgcn_cosf(fr), __builtin_amdgcn_sinf(fr)};
        const f32x2 dw = {0.99999970588366f, 7.6699031874270e-4f};
        const f32x2* xl = x + tt * 17; const f32x2* xh = x + 4352 + tt * 17;
        float r0[16], r1[16];
#pragma unroll
        for (int k = 0; k < 16; ++k) {
          const f32x2 y = (xl[k] + cmul(xh[k], wq)) * (1.f / 8192.f);
          wq = cmul(wq, dw);
          const unsigned ua = k < 8 ? a0[k >> 1] : a1[(k - 8) >> 1], ub = k < 8 ? b0v[k >> 1] : b1v[(k - 8) >> 1];
          const unsigned uc = k < 8 ? c0[k >> 1] : c1[(k - 8) >> 1], ud = k < 8 ? d0[k >> 1] : d1[(k - 8) >> 1];
          const float v0 = (k & 1) ? __uint_as_float(ua & 0xffff0000u) : __uint_as_float(ua << 16);
          const float v1 = (k & 1) ? __uint_as_float(ub & 0xffff0000u) : __uint_as_float(ub << 16);
          const float g0 = (k & 1) ? __uint_as_float(uc & 0xffff0000u) : __uint_as_float(uc << 16);
          const float g1 = (k & 1) ? __uint_as_float(ud & 0xffff0000u) : __uint_as_float(ud << 16);
          r0[k] = g0 * (y[0] + bias * v0); r1[k] = g1 * (y[1] + bias * v1);
        }
        *(u32x4*)pv0 = (u32x4){pack2(r0[0], r0[1]), pack2(r0[2], r0[3]), pack2(r0[4], r0[5]), pack2(r0[6], r0[7])};
        *(u32x4*)(pv0 + 8) = (u32x4){pack2(r0[8], r0[9]), pack2(r0[10], r0[11]), pack2(r0[12], r0[13]), pack2(r0[14], r0[15])};
        *(u32x4*)pv1 = (u32x4){pack2(r1[0], r1[1]), pack2(r1[2], r1[3]), pack2(r1[4], r1[5]), pack2(r1[6], r1[7])};
        *(u32x4*)(pv1 + 8) = (u32x4){pack2(r1[8], r1[9]), pack2(r1[10], r1[11]), pack2(r1[12], r1[13]), pack2(r1[14], r1[15])};
      }
      __syncthreads();
    }
  }
  __syncthreads();
}

DI void hyena_ctx_item(const Params& p, int w, char* smem) {
  float* F = (float*)smem; float* Bk = F + 256; float* vin = Bk + 256; float* sc = vin + 256;
  const int tid = otid(), t = tid;
  u16* uT = (u16*)(p.ws + OFF_UT);
  u16* vrow = uT + (long)(1024 + w) * MT + RL;
  const float* h2c = (const float*)(p.ws + OFF_H2C);
  const float* w3 = p.in[16];
  const float* cw = p.in[10], *cb = p.in[11];
  const float absd = -(HY_MIN_DECAY + (float)w * ((HY_MAX_DECAY - HY_MIN_DECAY) / 511.f));
  const float vw0 = cw[1024 + w], vw1 = cw[1536 + 1024 + w], vw2 = cw[3072 + 1024 + w], vbb = cb[1024 + w];
  float vv[8];
#pragma unroll
  for (int b = 0; b < 8; ++b) vv[b] = sconv(vrow, (long)b * 256, t, 256, vw0, vw1, vw2, vbb);
#pragma unroll 1
  for (int o = 0; o < 2; ++o) {
    const u16* grow = uT + (long)(o * 512 + w) * MT + RL;
    const float gw0 = cw[o * 512 + w], gw1 = cw[1536 + o * 512 + w], gw2 = cw[3072 + o * 512 + w], gbb = cb[o * 512 + w];
    const float bias = p.in[18][o * 512 + w];
    __syncthreads();
    {
      float df = 0.f, db = 0.f;
      for (int k = 0; k < 64; ++k) { const float hv = h2c[t * 64 + k]; df += hv * w3[k * 2048 + o * 512 + w]; db += hv * w3[k * 2048 + 1024 + o * 512 + w]; }
      const float win = __expf(-((float)t * (1.f / 255.f)) * absd);
      const float f = df * win, bk = db * win;
      F[t] = f; Bk[t] = bk;
      float asum = fabsf(f) + (t > 0 ? fabsf(bk) : 0.f);
      asum = wave_sum(asum);
      if ((tid & 63) == 0) sc[tid >> 6] = asum;
    }
    __syncthreads();
    const float inorm = 1.f / (sc[0] + sc[1] + sc[2] + sc[3]);
#pragma unroll
    for (int b = 0; b < 8; ++b) {
      vin[t] = vv[b];
      __syncthreads();
      float y = 0.f;
      for (int s = 0; s <= t; ++s) y += F[t - s] * vin[s];
      for (int s = t + 1; s < 256; ++s) y += Bk[s - t] * vin[s];
      const float g = sconv(grow, (long)b * 256, t, 256, gw0, gw1, gw2, gbb);
      vv[b] = g * (y * inorm + bias * vv[b]);
      __syncthreads();
    }
  }
#pragma unroll
  for (int b = 0; b < 8; ++b) vrow[(long)b * 256 + t] = f2bf(vv[b]);
  __syncthreads();
}

constexpr int NPHASE = 20;
constexpr int MTILES = MT / 128, LTILES = RL / 128;

DI void run_phase(const Params& pin, int ph, char* smem, int vb, int nvb) {
  Params p = pin;
  asm volatile("" : "+s"(p.ws), "+s"(p.out));
  if (ph == 0) {
    for (int it = vb; it < 4096 + 192 + 2112 + 256 + 256; it += nvb) {
      if (it < 4096) wconv_item(p, 0, it, smem);
      else if (it < 4288) mod_item(p, it - 4096, smem);
      else if (it < 6400) h2_item(p, it - 4288, smem);
      else if (it < 6656) rope_item(p, it - 6400);
      else {
        const f32x4* src = (const f32x4*)p.in[2] + (long)(it - 6656) * 2048; f32x4* dst = (f32x4*)(p.ws + OFF_HC) + (long)(it - 6656) * 2048;
        for (int k = otid(); k < 2048; k += 256) dst[k] = src[k];
      }
    }
    return;
  }
  if (ph == NPHASE - 1) { final_norm(p, vb, nvb); return; }
  const int layer = (ph - 1) / 9, sub = (ph - 1) % 9;
  const int mtl = layer == 0 ? MTILES : LTILES;
#define TILE_LOOP(T, NT, OFFS, CALL)                                                     \
  for (int it_ = vb; it_ < ((T) + nvb - 1) / nvb * nvb; it_ += nvb) {                     \
    const int tl_ = ((it_ / nvb) * 8 + (vb & 7)) * (nvb >> 3) + (vb >> 3);                \
    if (tl_ < (T)) {                                                                      \
      const int sr_ = tl_ / (8 * (NT)), rem_ = tl_ - sr_ * 8 * (NT);                      \
      const int nt = rem_ >> 3, mt = (OFFS) + sr_ * 8 + (rem_ & 7);                       \
      CALL;                                                                               \
    }                                                                                     \
  }
  switch (sub) {
    case 0:
      norm_rows(p, layer, 0, vb, nvb);
      if (layer == 1) for (int it = vb; it < 4096; it += nvb) wconv_item(p, 1, it, smem);
      break;
    case 1: {
      TILE_LOOP(mtl * 17, 17, 0, gemm_tile<EPI_UIN>(p, layer, mt, nt, smem, 0))
      if (layer == 1) for (int e = vb; e < (MTILES - LTILES) * 2; e += nvb) gemm_tile<EPI_UIN>(p, layer, LTILES + (e >> 1), 7 + (e & 1), smem, 0);
    } break;
    case 2: {
      const int nhy = layer == 0 ? 1024 : 512;
      const bool gemm_first = vb >= (nvb >> 1);
#pragma unroll 1
      for (int pass = 0; pass < 2; ++pass) {
        if ((pass == 0) != gemm_first) {
          for (int it = vb; it < nhy; it += nvb) {
            if (it < 512) hyena_lat_item(p, layer, it, smem);
            else hyena_ctx_item(p, it - 512, smem);
          }
        } else {
          TILE_LOOP(mtl * 6, 6, 0, gemm_tile<EPI_QUP>(p, layer, mt, nt, smem, 0))
          TILE_LOOP(MTILES * 8, 8, 0, gemm_tile<EPI_KVUP>(p, layer, mt, nt, smem, 0))
        }
      }
    } break;
    case 3: {
      const int nlat = NBATCH * NH * 16, nctx = layer == 0 ? NBATCH * NH : 0;
      for (int it_ = vb; it_ < (nlat + nvb - 1) / nvb * nvb; it_ += nvb) {
        const int it = ((it_ / nvb) * 8 + (vb & 7)) * (nvb >> 3) + (vb >> 3);
        if (it < nlat) attn_item(p, false, it >> 8, (it >> 4) & 15, it & 15, smem);
      }
      for (int e = vb; e < nctx; e += nvb) attn_item(p, true, e >> 4, e & 15, 0, smem);
    } break;
    case 4: TILE_LOOP(mtl * 8, 8, 0, gemm_tile<EPI_G1>(p, layer, mt, nt, smem, 0)) break;
    case 5:
      TILE_LOOP(LTILES * 4, 4, 0, gemm_tile<EPI_RES>(p, layer, mt, nt, smem, 0))
      if (layer == 0) for (int e = vb; e < (MTILES - LTILES) * 4 * 8; e += nvb) gemm_tile<EPI_RES>(p, layer, LTILES + (e >> 5), (e >> 3) & 3, smem, 0, e & 7);
      break;
    case 6: norm_rows(p, layer, 1, vb, nvb); break;
    case 7: TILE_LOOP(mtl * 22, 22, 0, gemm_tile<EPI_FFNIN>(p, layer, mt, nt, smem, 0)) break;
    case 8:
      TILE_LOOP(LTILES * 4, 4, 0, gemm_tile<EPI_RES>(p, layer, mt, nt, smem, 1))
      if (layer == 0) for (int e = vb; e < (MTILES - LTILES) * 4 * 8; e += nvb) gemm_tile<EPI_RES>(p, layer, LTILES + (e >> 5), (e >> 3) & 3, smem, 1, e & 7);
      break;
  }
#undef TILE_LOOP
}

DI void fast_grid_sync(unsigned* ctr, unsigned target) {
  asm volatile("s_waitcnt vmcnt(0)" ::: "memory");
  __syncthreads();
  if (threadIdx.x == 0) {
    __builtin_amdgcn_fence(__ATOMIC_RELEASE, "agent");
    asm volatile("s_waitcnt vmcnt(0)" ::: "memory");
    __hip_atomic_fetch_add(ctr, 1u, __ATOMIC_RELAXED, __HIP_MEMORY_SCOPE_AGENT);
    while (__hip_atomic_load(ctr, __ATOMIC_RELAXED, __HIP_MEMORY_SCOPE_AGENT) < target) __builtin_amdgcn_s_sleep(1);
    __builtin_amdgcn_fence(__ATOMIC_ACQUIRE, "agent");
    asm volatile("s_waitcnt vmcnt(0)" ::: "memory");
  }
  __syncthreads();
}

__global__ void __launch_bounds__(NTHREADS, 2) mega_kernel(Params p) {
  extern __shared__ __attribute__((aligned(16))) char smem[];
  cg::grid_group grid = cg::this_grid();
  for (int ph = 0; ph < NPHASE; ++ph) {
    run_phase(p, ph, smem, blockIdx.x, gridDim.x);
    if (ph == 0) {
      if (blockIdx.x == 0 && threadIdx.x == 0) __hip_atomic_store((unsigned*)(p.ws + OFF_BAR), 0u, __ATOMIC_RELAXED, __HIP_MEMORY_SCOPE_AGENT);
      grid.sync();
    } else if (ph + 1 < NPHASE) {
      fast_grid_sync((unsigned*)(p.ws + OFF_BAR), (unsigned)ph * gridDim.x);
    }
  }
}

#if MULTI_LAUNCH
__global__ void __launch_bounds__(NTHREADS, 2) phase_kernel(Params p, int ph) {
  extern __shared__ __attribute__((aligned(16))) char smem[];
  run_phase(p, ph, smem, blockIdx.x, gridDim.x);
}
#endif

extern "C" void kernel_launch(void* const* d_in, const int* in_sizes, int n_in, void* d_out, int out_size, void* d_ws, size_t ws_size,
                              hipStream_t stream) {
  static int grid_blocks = 0;
  if (!grid_blocks) {
    int dev = 0, cus = 0, per_cu = 0;
    (void)hipGetDevice(&dev);
    (void)hipDeviceGetAttribute(&cus, hipDeviceAttributeMultiprocessorCount, dev);
    (void)hipFuncSetAttribute((const void*)mega_kernel, hipFuncAttributeMaxDynamicSharedMemorySize, LDS_BYTES);
#if MULTI_LAUNCH
    (void)hipFuncSetAttribute((const void*)phase_kernel, hipFuncAttributeMaxDynamicSharedMemorySize, LDS_BYTES);
#endif
    (void)hipOccupancyMaxActiveBlocksPerMultiprocessor(&per_cu, mega_kernel, NTHREADS, LDS_BYTES);
    if (per_cu < 1) per_cu = 1;
    if (per_cu > 2) per_cu = 2;
    grid_blocks = cus * per_cu;
  }
  Params p{};
  for (int i = 0; i < 29; ++i) p.in[i] = (const float*)d_in[i];
  p.out = (float*)d_out;
  p.ws = (char*)d_ws;
  if (ws_size < WS_END + 256) { fprintf(stderr, "workspace too small\n"); return; }
#if MULTI_LAUNCH
  for (int ph = 0; ph < NPHASE; ++ph) hipLaunchKernelGGL(phase_kernel, dim3(grid_blocks), dim3(NTHREADS), LDS_BYTES, stream, p, ph);
#else
  void* args[] = {&p};
  hipError_t e = hipLaunchCooperativeKernel((void*)mega_kernel, dim3(grid_blocks), dim3(NTHREADS), args, LDS_BYTES, stream);
  if (e != hipSuccess) fprintf(stderr, "cooperative launch failed: %s (grid %d)\n", hipGetErrorString(e), grid_blocks);
#endif
}
```

```cpp
#include <hip/hip_runtime.h>
#include <hip/hip_cooperative_groups.h>
#include <cstdio>
#include <type_traits>
namespace cg = cooperative_groups;

#ifndef MULTI_LAUNCH
#define MULTI_LAUNCH 0
#endif

#define DI __device__ __forceinline__
typedef unsigned short u16;
typedef __attribute__((ext_vector_type(8))) short bf16x8;
typedef __attribute__((ext_vector_type(16))) float f32x16;
typedef __attribute__((ext_vector_type(4))) float f32x4;
typedef __attribute__((ext_vector_type(2))) float f32x2;
typedef __attribute__((ext_vector_type(4))) unsigned u32x4;
typedef __attribute__((ext_vector_type(2))) unsigned u32x2;
typedef __attribute__((ext_vector_type(2))) __bf16 bf16x2_t;
typedef __attribute__((ext_vector_type(2))) _Float16 f16x2_t;

constexpr int DM = 1024, NBATCH = 8, SEQ = 4096, CTXL = 256;
constexpr int RL = NBATCH * SEQ, RC = NBATCH * CTXL, MT = RL + RC;
constexpr int HYW = 512, QL = 384, KVL = 256, NH = 16, DFF = 2816;
constexpr int KEYS = SEQ + CTXL;
constexpr int INC = 4256, OFFG = 2208;
constexpr float EPS = 1e-6f;
constexpr int LDS_BYTES = 74752;
constexpr int NTHREADS = 256;

constexpr size_t SZ_Q = (size_t)MT * 1536 * 2, SZ_A = (size_t)MT * 1024 * 2, SZ_CQ = (size_t)MT * QL * 2,
                 SZ_CKV = (size_t)MT * KVL * 2, SZ_KR = (size_t)MT * 32 * 2, SZ_UT = (size_t)1536 * MT * 2;
constexpr size_t OFF_Q = 0, OFF_A = OFF_Q + SZ_Q, OFF_CQ = OFF_A + SZ_A, OFF_CKV = OFF_CQ + SZ_CQ, OFF_KR = OFF_CKV + SZ_CKV,
                 OFF_KN = OFF_KR + SZ_KR, OFF_VT = OFF_KN + SZ_A, OFF_UT = OFF_VT + SZ_A, OFF_WT = OFF_UT + SZ_UT;
constexpr long WIN_O = 0, WUQ_O = WIN_O + 4256L * 1024, WUKV_O = WUQ_O + 1536L * 384, WHY_O = WUKV_O + 2048L * 256,
               WMLA_O = WHY_O + 1024L * 512, WOUT_O = WMLA_O + 1024L * 1024, WFIN_O = WOUT_O + 1024L * 1024,
               WFOUT_O = WFIN_O + 5632L * 1024, WT_ELEMS = WFOUT_O + 1024L * 2816;
constexpr size_t OFF_HC = OFF_WT + (size_t)WT_ELEMS * 2, OFF_MOD = OFF_HC + (size_t)RC * 1024 * 4,
                 OFF_H2 = OFF_MOD + (size_t)2 * 9 * 6144 * 4, OFF_H2C = OFF_H2 + (size_t)2 * 4096 * 64 * 4,
                 OFF_ROPE = OFF_H2C + (size_t)256 * 64 * 4, WS_END = OFF_ROPE + (size_t)2 * 4096 * 16 * 4;
constexpr size_t OFF_G8 = OFF_Q;
constexpr size_t OFF_QN = OFF_Q + SZ_A;
static_assert(OFF_QN + SZ_Q == OFF_CQ, "q must end where cq starts");
static_assert((size_t)2048 * MT <= SZ_A, "gate8 fits below q");
constexpr size_t OFF_BAR = WS_END;
static_assert(WS_END + 256 <= 536870912ull, "workspace too large");
static_assert((size_t)MT * DFF * 2 <= SZ_A * 2 + SZ_UT, "act does not fit");

struct Params {
  const float* in[29];
  float* out;
  char* ws;
};

DI int otid() { int t = threadIdx.x; asm volatile("" : "+v"(t)); return t; }
DI unsigned pack2(float lo, float hi) { f32x2 v = {lo, hi}; bf16x2_t b = __builtin_convertvector(v, bf16x2_t); return __builtin_bit_cast(unsigned, b); }
DI u16 f2bf(float x) { return (u16)(pack2(x, 0.f) & 0xffffu); }
DI float bf2f(u16 b) { return __uint_as_float((unsigned)b << 16); }
DI int crow(int r, int hi) { return (r & 3) + 8 * (r >> 2) + 4 * hi; }
DI float sigmoidf_(float x) { return __builtin_amdgcn_rcpf(1.f + __expf(-x)); }
DI float wave_sum(float v) {
#pragma unroll
  for (int o = 32; o >= 1; o >>= 1) v += __shfl_xor(v, o);
  return v;
}
DI float dpp_swap1(float v) { return __builtin_bit_cast(float, __builtin_amdgcn_mov_dpp(__builtin_bit_cast(int, v), 0xB1, 0xF, 0xF, true)); }
DI void store_tile_bf16(u16* dst, long ld, const float (&v)[16], int r32, int hi) {
  const bool odd = r32 & 1;
#pragma unroll
  for (int rp = 0; rp < 8; ++rp) {
    const float a = v[2 * rp], b = v[2 * rp + 1];
    const float recv = dpp_swap1(odd ? a : b);
    const int row = ((2 * rp) & 3) + 8 * ((2 * rp) >> 2) + 4 * hi + (odd ? 1 : 0);
    const unsigned w = odd ? pack2(recv, b) : pack2(a, recv);
    *(unsigned*)(dst + (long)row * ld + (r32 & ~1)) = w;
  }
}
#define MFMA32(a, b, c) __builtin_amdgcn_mfma_f32_32x32x16_bf16((a), (b), (c), 0, 0, 0)

DI void wconv_item(const Params& p, int layer, int it, char* smem) {
  int K, N; const float* W; const float* g = nullptr; long woff;
  if (it < 1072) { K = 1024; N = 4256; W = p.in[8] + (long)layer * 1024 * 4256; woff = WIN_O; }
  else if ((it -= 1072) < 144) { K = 384; N = 1536; W = p.in[22] + (long)layer * 384 * 1536; g = p.in[20] + layer * 384; woff = WUQ_O; }
  else if ((it -= 144) < 128) { K = 256; N = 2048; W = p.in[23] + (long)layer * 256 * 2048; g = p.in[21] + layer * 256; woff = WUKV_O; }
  else if ((it -= 128) < 128) { K = 512; N = 1024; W = p.in[19] + (long)layer * 512 * 1024; woff = WHY_O; }
  else if ((it -= 128) < 256) { K = 1024; N = 1024; W = p.in[24] + (long)layer * 1024 * 1024; woff = WMLA_O; }
  else if ((it -= 256) < 256) { K = 1024; N = 1024; W = p.in[25] + (long)layer * 1024 * 1024; woff = WOUT_O; }
  else if ((it -= 256) < 1408) { K = 1024; N = 5632; W = p.in[26] + (long)layer * 1024 * 5632; woff = WFIN_O; }
  else { it -= 1408; K = 2816; N = 1024; W = p.in[27] + (long)layer * 2816 * 1024; woff = WFOUT_O; }
  const int nts = (N + 63) >> 6;
  const int kt = it / nts, nt = it - kt * nts;
  u16* tile = (u16*)smem;
  u16* Wt = (u16*)(p.ws + OFF_WT) + woff;
  const int tid = otid();
  {
    const int r = tid >> 4, c4 = tid & 15;
#pragma unroll
    for (int i = 0; i < 4; ++i) {
      const int kk = r + 16 * i, k = kt * 64 + kk, n = nt * 64 + c4 * 4;
      f32x4 v = {0.f, 0.f, 0.f, 0.f};
      if (n < N) v = *(const f32x4*)(W + (long)k * N + n);
      const float s = g ? g[k] : 1.f;
      tile[kk * 66 + c4 * 4 + 0] = f2bf(v[0] * s); tile[kk * 66 + c4 * 4 + 1] = f2bf(v[1] * s);
      tile[kk * 66 + c4 * 4 + 2] = f2bf(v[2] * s); tile[kk * 66 + c4 * 4 + 3] = f2bf(v[3] * s);
    }
  }
  __syncthreads();
  {
    const int n = tid >> 2, kc = tid & 3;
    if (nt * 64 + n < N) {
      unsigned w[8];
#pragma unroll
      for (int e = 0; e < 8; ++e) w[e] = (unsigned)tile[(kc * 16 + 2 * e) * 66 + n] | ((unsigned)tile[(kc * 16 + 2 * e + 1) * 66 + n] << 16);
      u32x4* dst = (u32x4*)(Wt + (long)(nt * 64 + n) * K + kt * 64 + kc * 16);
      dst[0] = (u32x4){w[0], w[1], w[2], w[3]}; dst[1] = (u32x4){w[4], w[5], w[6], w[7]};
    }
  }
  __syncthreads();
}

DI void mod_item(const Params& p, int it, char* smem) {
  const int layer = it / 96, n0 = (it % 96) * 64, tid = otid();
  float* s = (float*)smem;
  float* red = s + 9216;
  for (int idx = tid; idx < 9216; idx += 256) {
    const int r = idx >> 10, k = idx & 1023;
    const float cv = r < 8 ? p.in[1][r * 1024 + k] : p.in[3][k];
    s[idx] = cv / (1.f + expf(-cv));
  }
  __syncthreads();
  const int kq = tid >> 6, nn = tid & 63;
  float acc[9];
#pragma unroll
  for (int r = 0; r < 9; ++r) acc[r] = 0.f;
  const float* W = p.in[4] + (long)layer * 1024 * 6144 + n0 + nn;
  for (int k = kq; k < 1024; k += 4) {
    const float w = W[(long)k * 6144];
#pragma unroll
    for (int r = 0; r < 9; ++r) acc[r] += s[r * 1024 + k] * w;
  }
#pragma unroll
  for (int r = 0; r < 9; ++r) red[(kq * 9 + r) * 64 + nn] = acc[r];
  __syncthreads();
  float* mod = (float*)(p.ws + OFF_MOD);
  for (int idx = tid; idx < 576; idx += 256) {
    const int r = idx >> 6, c = idx & 63;
    float v = p.in[5][layer * 6144 + n0 + c];
#pragma unroll
    for (int q = 0; q < 4; ++q) v += red[(q * 9 + r) * 64 + c];
    mod[(layer * 9 + r) * 6144 + n0 + c] = v;
  }
  __syncthreads();
}

DI void h2_item(const Params& p, int it, char* smem) {
  int set, row4;
  if (it < 1024) { set = 0; row4 = it; } else if (it < 2048) { set = 1; row4 = it - 1024; } else { set = 2; row4 = it - 2048; }
  const int L = set < 2 ? 4096 : 256, layer = set == 1 ? 1 : 0;
  float* dst = set < 2 ? (float*)(p.ws + OFF_H2) + (long)set * 4096 * 64 : (float*)(p.ws + OFF_H2C);
  const int tid = otid(), rr = tid >> 6, c = tid & 63, row = row4 * 4 + rr;
  const float t = (float)row / (float)(L - 1);
  float* zs = (float*)smem;
  float* h1s = zs + 4 * 36;
  if (c < 33) {
    float val;
    if (c == 0) val = t; else if (c <= 16) val = cospif(2.f * (float)c * t); else val = sinpif(2.f * (float)(c - 16) * t);
    zs[rr * 36 + c] = val;
  }
  __syncthreads();
  const float* w1 = p.in[12] + layer * 33 * 64, *b1 = p.in[13] + layer * 64, *w2 = p.in[14] + layer * 64 * 64, *b2 = p.in[15] + layer * 64;
  const float* fr = p.in[17] + layer * 128;
  float a = b1[c];
  for (int i = 0; i < 33; ++i) a += zs[rr * 36 + i] * w1[i * 64 + c];
  h1s[rr * 64 + c] = sinf(fr[c] * a);
  __syncthreads();
  a = b2[c];
  for (int k = 0; k < 64; ++k) a += h1s[rr * 64 + k] * w2[k * 64 + c];
  dst[(long)row * 64 + c] = sinf(fr[64 + c] * a);
  __syncthreads();
}

DI void rope_item(const Params& p, int it) {
  const int idx = it * 256 + otid(), t = idx >> 4, i = idx & 15;
  const float pos = (float)(i < 8 ? (t >> 6) : (t & 63));
  const float inv = exp2f(-(float)(i & 7) * (13.287712379549449f / 8.f));
  float sn, cs; sincosf(pos * inv, &sn, &cs);
  float* rc = (float*)(p.ws + OFF_ROPE);
  rc[idx] = cs; rc[4096 * 16 + idx] = sn;
}

DI void norm_rows(const Params& p, int layer, int which, int vb, int nvb) {
  const int lane = otid() & 63, wv = vb * 4 + (otid() >> 6), nwv = nvb * 4;
  const float* mod = (const float*)(p.ws + OFF_MOD) + (long)layer * 9 * 6144;
  const float* g = p.in[which ? 7 : 6] + layer * 1024;
  u16* a = (u16*)(p.ws + OFF_A);
  const bool first = (layer == 0 && which == 0);
  for (int row0 = wv; row0 < MT; row0 += 2 * nwv) {
    const int row1 = row0 + nwv;
    const bool has1 = row1 < MT;
    const float* src[2]; int bb[2];
#pragma unroll
    for (int u = 0; u < 2; ++u) {
      const int row = u == 0 ? row0 : (has1 ? row1 : row0);
      if (row < RL) { bb[u] = row >> 12; src[u] = (first ? p.in[0] : p.out) + (long)row * 1024; }
      else { bb[u] = 8; src[u] = (first ? p.in[2] : (const float*)(p.ws + OFF_HC)) + (long)(row - RL) * 1024; }
    }
    f32x4 v[2][4];
#pragma unroll
    for (int u = 0; u < 2; ++u)
#pragma unroll
      for (int i = 0; i < 4; ++i) v[u][i] = *(const f32x4*)(src[u] + i * 256 + lane * 4);
#pragma unroll
    for (int u = 0; u < 2; ++u) {
      if (u == 1 && !has1) break;
      const int row = u == 0 ? row0 : row1;
      float ss = 0.f;
#pragma unroll
      for (int i = 0; i < 4; ++i) ss += v[u][i][0] * v[u][i][0] + v[u][i][1] * v[u][i][1] + v[u][i][2] * v[u][i][2] + v[u][i][3] * v[u][i][3];
      ss = wave_sum(ss);
      const float rstd = rsqrtf(ss * (1.f / 1024.f) + EPS);
      const float* sh = mod + bb[u] * 6144 + (which ? 3 : 0) * 1024, *sc = sh + 1024;
#pragma unroll
      for (int i = 0; i < 4; ++i) {
        const int k = i * 256 + lane * 4;
        const f32x4 gv = *(const f32x4*)(g + k), scv = *(const f32x4*)(sc + k), shv = *(const f32x4*)(sh + k);
        float o0 = v[u][i][0] * rstd * gv[0] * (1.f + scv[0]) + shv[0], o1 = v[u][i][1] * rstd * gv[1] * (1.f + scv[1]) + shv[1];
        float o2 = v[u][i][2] * rstd * gv[2] * (1.f + scv[2]) + shv[2], o3 = v[u][i][3] * rstd * gv[3] * (1.f + scv[3]) + shv[3];
        *(u32x2*)(a + (long)row * 1024 + k) = (u32x2){pack2(o0, o1), pack2(o2, o3)};
      }
    }
  }
}

DI void final_norm(const Params& p, int vb, int nvb) {
  const int lane = otid() & 63, wv = vb * 4 + (otid() >> 6), nwv = nvb * 4;
  const float* g = p.in[28];
  for (int row = wv; row < RL; row += nwv) {
    float* src = p.out + (long)row * 1024;
    f32x4 v[4]; float ss = 0.f;
#pragma unroll
    for (int i = 0; i < 4; ++i) { v[i] = *(const f32x4*)(src + i * 256 + lane * 4); ss += v[i][0] * v[i][0] + v[i][1] * v[i][1] + v[i][2] * v[i][2] + v[i][3] * v[i][3]; }
    ss = wave_sum(ss);
    const float rstd = rsqrtf(ss * (1.f / 1024.f) + EPS);
#pragma unroll
    for (int i = 0; i < 4; ++i) {
      const int k = i * 256 + lane * 4;
      const f32x4 gv = *(const f32x4*)(g + k);
      *(f32x4*)(src + k) = (f32x4){v[i][0] * rstd * gv[0], v[i][1] * rstd * gv[1], v[i][2] * rstd * gv[2], v[i][3] * rstd * gv[3]};
    }
  }
}

constexpr int LDT = 32;
constexpr int BUFSZ = 384 * LDT;
template <bool G0, bool G1, bool AKM, bool ROWSS>
DI void kloop(f32x16 (&acc)[2][4], const u16* __restrict__ A, int lda, int K, const u16* __restrict__ Bg0, const u16* __restrict__ Bg1, int ldb,
              u16* As, u16* Bs, float& ss0, float& ss1) {
  const int tid = otid(), lane = tid & 63, wave = tid >> 6, wm = wave >> 1, wn = wave & 1, r32 = lane & 31, hi = lane >> 5;
  u32x4 ra[2], rb0[2], rb1[2];
  const int lrow = tid >> 2, lkc = tid & 3;
  const int tk = tid >> 4, tmc = tid & 15;
#define GLOAD(k0)                                                                                              \
  do {                                                                                                         \
    if (!AKM) { _Pragma("unroll") for (int i = 0; i < 2; ++i) ra[i] = *(const u32x4*)(A + (long)(lrow + 64 * i) * lda + (k0) + lkc * 8); } \
    else      { _Pragma("unroll") for (int i = 0; i < 2; ++i) ra[i] = *(const u32x4*)(A + (long)((k0) + tk + 16 * i) * lda + tmc * 8); }  \
    if (G0) { _Pragma("unroll") for (int i = 0; i < 2; ++i) rb0[i] = *(const u32x4*)(Bg0 + (long)(lrow + 64 * i) * ldb + (k0) + lkc * 8); } \
    if (G1) { _Pragma("unroll") for (int i = 0; i < 2; ++i) rb1[i] = *(const u32x4*)(Bg1 + (long)(lrow + 64 * i) * ldb + (k0) + lkc * 8); } \
  } while (0)
#define SWZ(row, c) ((row) * LDT + (((c) ^ (((row) >> 2) & 3)) << 3))
#define LSTORE(AsD, BsD)                                                                                       \
  do {                                                                                                         \
    if (!AKM) {                                                                                                \
      _Pragma("unroll") for (int i = 0; i < 2; ++i) *(u32x4*)((AsD) + SWZ(lrow + 64 * i, lkc)) = ra[i]; \
      if (ROWSS) {                                                                                             \
        _Pragma("unroll") for (int e = 0; e < 4; ++e) {                                                        \
          float a0 = __uint_as_float(ra[0][e] << 16), a1 = __uint_as_float(ra[0][e] & 0xffff0000u);           \
          float c0 = __uint_as_float(ra[1][e] << 16), c1 = __uint_as_float(ra[1][e] & 0xffff0000u);           \
          ss0 += a0 * a0 + a1 * a1; ss1 += c0 * c0 + c1 * c1;                                                  \
        }                                                                                                      \
      }                                                                                                        \
    } else {                                                                                                   \
      _Pragma("unroll") for (int i = 0; i < 2; ++i) {                                                          \
        _Pragma("unroll") for (int e = 0; e < 8; ++e) (AsD)[SWZ(tmc * 8 + e, (tk + 16 * i) >> 3) + ((tk + 16 * i) & 7)] = (u16)(ra[i][e >> 1] >> (16 * (e & 1))); \
      }                                                                                                        \
    }                                                                                                          \
    if (G0) { _Pragma("unroll") for (int i = 0; i < 2; ++i) *(u32x4*)((BsD) + SWZ(lrow + 64 * i, lkc)) = rb0[i]; }       \
    if (G1) { _Pragma("unroll") for (int i = 0; i < 2; ++i) *(u32x4*)((BsD) + SWZ(128 + lrow + 64 * i, lkc)) = rb1[i]; } \
  } while (0)
  GLOAD(0);
  __syncthreads();
  LSTORE(As, Bs);
  if (32 < K) GLOAD(32);
  __syncthreads();
#pragma unroll 2
  for (int k0 = 0; k0 < K; k0 += 32) {
    const int cur = (k0 >> 5) & 1;
    const u16* Ac = As + cur * BUFSZ; const u16* Bc = Bs + cur * BUFSZ;
    if (k0 + 32 < K) { u16* An = As + (cur ^ 1) * BUFSZ; u16* Bn = Bs + (cur ^ 1) * BUFSZ; LSTORE(An, Bn); }
    if (k0 + 64 < K) GLOAD(k0 + 64);
#pragma unroll
    for (int ks = 0; ks < 2; ++ks) {
      bf16x8 af[2], bfr[4];
#pragma unroll
      for (int i = 0; i < 2; ++i) af[i] = *(const bf16x8*)(Ac + SWZ(wm * 64 + i * 32 + r32, ks * 2 + hi));
      if (G0) {
#pragma unroll
        for (int j = 0; j < 2; ++j) bfr[j] = *(const bf16x8*)(Bc + SWZ(wn * 64 + j * 32 + r32, ks * 2 + hi));
      }
      if (G1) {
#pragma unroll
        for (int j = 0; j < 2; ++j) bfr[2 + j] = *(const bf16x8*)(Bc + SWZ(128 + wn * 64 + j * 32 + r32, ks * 2 + hi));
      }
#pragma unroll
      for (int i = 0; i < 2; ++i) {
        if (G0) { acc[i][0] = MFMA32(af[i], bfr[0], acc[i][0]); acc[i][1] = MFMA32(af[i], bfr[1], acc[i][1]); }
        if (G1) { acc[i][2] = MFMA32(af[i], bfr[2], acc[i][2]); acc[i][3] = MFMA32(af[i], bfr[3], acc[i][3]); }
      }
    }
    __syncthreads();
  }
#undef LSTORE
#undef SWZ
#undef GLOAD
}

#define SWZ(row, c) ((row) * LDT + (((c) ^ (((row) >> 2) & 3)) << 3))
DI void glds16(const u16* g, u16* l) { __builtin_amdgcn_global_load_lds((const unsigned*)g, (unsigned*)l, 16, 0, 0); }
template <bool G0, bool G1, bool ROWSS = false>
DI void kloop_dma(f32x16 (&acc)[2][4], const u16* __restrict__ A, int lda, int K, const u16* __restrict__ Bg0, const u16* __restrict__ Bg1, int ldb, u16* L,
                  float* ssp0 = nullptr, float* ssp1 = nullptr) {
  const int tid = otid(), lane = tid & 63, wave = tid >> 6, wm = wave >> 1, wn = wave & 1, r32 = lane & 31, hi = lane >> 5;
  const int row0 = 16 * wave + (lane >> 2), lc = (lane & 3) ^ ((row0 >> 2) & 3);
  const u16* ga0 = A + (long)row0 * lda + lc * 8; const u16* ga1 = ga0 + (long)64 * lda;
  const u16* gb00 = Bg0 + (long)row0 * ldb + lc * 8; const u16* gb01 = gb00 + (long)64 * ldb;
  const u16* gb10 = Bg1 + (long)row0 * ldb + lc * 8; const u16* gb11 = gb10 + (long)64 * ldb;
  constexpr int NL = 2 + (G0 ? 2 : 0) + (G1 ? 2 : 0);
#define ISSUE(kt, bsel)                                                                              \
  do {                                                                                               \
    u16* Lb = L + (bsel) * BUFSZ; const int ko = (kt) * 32;                                          \
    glds16(ga0 + ko, Lb + wave * 512); glds16(ga1 + ko, Lb + (wave + 4) * 512);                      \
    if (G0) { glds16(gb00 + ko, Lb + 4096 + wave * 512); glds16(gb01 + ko, Lb + 4096 + (wave + 4) * 512); } \
    if (G1) { glds16(gb10 + ko, Lb + 8192 + wave * 512); glds16(gb11 + ko, Lb + 8192 + (wave + 4) * 512); } \
  } while (0)
  asm volatile("s_waitcnt vmcnt(0)" ::: "memory");
  __syncthreads();
  const int nk = K >> 5;
  ISSUE(0, 0);
  if (nk > 1) ISSUE(1, 1);
  auto kstep = [&](int k, auto bufc) __attribute__((always_inline)) {
    constexpr int BUF = decltype(bufc)::value;
    if (k + 1 < nk) asm volatile("s_waitcnt vmcnt(%0)" ::"n"(NL) : "memory"); else asm volatile("s_waitcnt vmcnt(0)" ::: "memory");
    asm volatile("s_waitcnt lgkmcnt(0)" ::: "memory");
    __builtin_amdgcn_s_barrier();
    asm volatile("" ::: "memory");
    const u16* Ac = L + BUF * BUFSZ; const u16* Bc = Ac + 128 * LDT;
    if (ROWSS) {
#pragma unroll
      for (int i = 0; i < 2; ++i) {
        const u32x4 c = *(const u32x4*)(Ac + SWZ((tid >> 2) + 64 * i, tid & 3));
        float sacc = 0.f;
#pragma unroll
        for (int e = 0; e < 4; ++e) { const float a0 = __uint_as_float(c[e] << 16), a1 = __uint_as_float(c[e] & 0xffff0000u); sacc += a0 * a0 + a1 * a1; }
        if (i == 0) *ssp0 += sacc; else *ssp1 += sacc;
      }
    }
#pragma unroll
    for (int ks = 0; ks < 2; ++ks) {
      bf16x8 af[2], bfr[4];
#pragma unroll
      for (int i = 0; i < 2; ++i) af[i] = *(const bf16x8*)(Ac + SWZ(wm * 64 + i * 32 + r32, ks * 2 + hi));
      if (G0) {
#pragma unroll
        for (int j = 0; j < 2; ++j) bfr[j] = *(const bf16x8*)(Bc + SWZ(wn * 64 + j * 32 + r32, ks * 2 + hi));
      }
      if (G1) {
#pragma unroll
        for (int j = 0; j < 2; ++j) bfr[2 + j] = *(const bf16x8*)(Bc + SWZ(128 + wn * 64 + j * 32 + r32, ks * 2 + hi));
      }
      if (ks == 1 && k + 2 < nk) { ISSUE(k + 2, (BUF + 2) % 3); }
      __builtin_amdgcn_s_setprio(1);
#pragma unroll
      for (int i = 0; i < 2; ++i) {
        if (G0) { acc[i][0] = MFMA32(af[i], bfr[0], acc[i][0]); acc[i][1] = MFMA32(af[i], bfr[1], acc[i][1]); }
        if (G1) { acc[i][2] = MFMA32(af[i], bfr[2], acc[i][2]); acc[i][3] = MFMA32(af[i], bfr[3], acc[i][3]); }
      }
      __builtin_amdgcn_s_setprio(0);
    }
  };
  int k3 = 0;
#pragma unroll 1
  for (; k3 + 3 <= nk; k3 += 3) {
    kstep(k3, std::integral_constant<int, 0>{}); kstep(k3 + 1, std::integral_constant<int, 1>{}); kstep(k3 + 2, std::integral_constant<int, 2>{});
  }
  if (k3 < nk) { kstep(k3, std::integral_constant<int, 0>{}); if (k3 + 1 < nk) kstep(k3 + 1, std::integral_constant<int, 1>{}); }
#undef ISSUE
}
#undef SWZ

DI float rope_apply(float v, int r32, int t, const float* rc) {
  const float partner = __shfl_xor(v, 16);
  const float cs = rc[t * 16 + (r32 & 15)], sn = rc[4096 * 16 + t * 16 + (r32 & 15)];
  return r32 < 16 ? v * cs - partner * sn : partner * sn + v * cs;
}

enum { EPI_UIN = 0, EPI_QUP, EPI_KVUP, EPI_G1, EPI_G2, EPI_RES, EPI_FFNIN };

template <int EPI>
DI void gemm_tile(const Params& p, int layer, int mt, int nt, char* smem, int resid_which, int ksl = -1) {
  u16* As = (u16*)smem; u16* Bs = As + 128 * LDT; float* rs = (float*)(As + 3 * BUFSZ);
  const int tid = otid(), lane = tid & 63, wave = tid >> 6, wm = wave >> 1, wn = wave & 1, r32 = lane & 31, hi = lane >> 5;
  const int m0 = mt * 128;
  const bool lat = m0 < RL;
  const int b = lat ? (m0 >> 12) : 8;
  const u16* Wt = (const u16*)(p.ws + OFF_WT);
  f32x16 acc[2][4];
#pragma unroll
  for (int i = 0; i < 2; ++i)
#pragma unroll
    for (int j = 0; j < 4; ++j)
#pragma unroll
      for (int r = 0; r < 16; ++r) acc[i][j][r] = 0.f;
  float ss0 = 0.f, ss1 = 0.f;
  const float* mod = (const float*)(p.ws + OFF_MOD) + ((long)layer * 9 + b) * 6144;
  const float* rc = (const float*)(p.ws + OFF_ROPE);

  if (EPI == EPI_UIN) {
    const u16* A = (const u16*)(p.ws + OFF_A) + (long)m0 * 1024;
    const u16* B0 = Wt + WIN_O + (long)(nt * 256) * 1024;
    kloop_dma<true, true>(acc, A, 1024, 1024, B0, B0 + 128 * 1024, 1024, As);
    u16* uT = (u16*)(p.ws + OFF_UT); u16* cq = (u16*)(p.ws + OFF_CQ); u16* ckv = (u16*)(p.ws + OFF_CKV); u16* kr = (u16*)(p.ws + OFF_KR);
#pragma unroll
    for (int j = 0; j < 4; ++j) {
      const int cb = nt * 256 + (j >> 1) * 128 + wn * 64 + (j & 1) * 32;
      const int col = cb + r32;
#pragma unroll
      for (int i = 0; i < 2; ++i) {
        const int mb = m0 + wm * 64 + i * 32;
        if (cb < 1536) {
#pragma unroll
          for (int g = 0; g < 4; ++g) {
            const u32x2 v = {pack2(acc[i][j][4 * g], acc[i][j][4 * g + 1]), pack2(acc[i][j][4 * g + 2], acc[i][j][4 * g + 3])};
            *(u32x2*)(uT + (long)col * MT + mb + 8 * g + 4 * hi) = v;
          }
        } else if (cb < 1920) {
          float v[16];
#pragma unroll
          for (int r = 0; r < 16; ++r) v[r] = acc[i][j][r];
          store_tile_bf16(cq + (long)mb * QL + (cb - 1536), QL, v, r32, hi);
        } else if (cb < 2176) {
          float v[16];
#pragma unroll
          for (int r = 0; r < 16; ++r) v[r] = acc[i][j][r];
          store_tile_bf16(ckv + (long)mb * KVL + (cb - 1920), KVL, v, r32, hi);
        } else if (cb < 2208) {
          float v[16];
#pragma unroll
          for (int r = 0; r < 16; ++r) {
            v[r] = acc[i][j][r];
            if (lat) v[r] = rope_apply(v[r], r32, (mb + crow(r, hi)) & 4095, rc);
          }
          store_tile_bf16(kr + (long)mb * 32, 32, v, r32, hi);
        } else if (cb < INC) {
          const int gc = col - OFFG;
          const float gbv = p.in[9][layer * 2048 + gc];
          unsigned char* g8 = (unsigned char*)(p.ws + OFF_G8) + (long)gc * MT + mb + 4 * hi;
#pragma unroll
          for (int g = 0; g < 4; ++g) {
            unsigned wv = 0;
#pragma unroll
            for (int e = 0; e < 4; ++e) wv |= (unsigned)(sigmoidf_(acc[i][j][4 * g + e] + gbv) * 255.f + 0.5f) << (8 * e);
            *(unsigned*)(g8 + 8 * g) = wv;
          }
        }
      }
    }
  } else if (EPI == EPI_QUP) {
    const u16* A = (const u16*)(p.ws + OFF_CQ) + (long)m0 * QL;
    const u16* B0 = Wt + WUQ_O + (long)(nt * 256) * QL;
    kloop_dma<true, true, true>(acc, A, QL, QL, B0, B0 + 128 * QL, QL, As, &ss0, &ss1);
    ss0 += __shfl_xor(ss0, 1); ss0 += __shfl_xor(ss0, 2); ss1 += __shfl_xor(ss1, 1); ss1 += __shfl_xor(ss1, 2);
    if ((tid & 3) == 0) { rs[tid >> 2] = rsqrtf(ss0 * (1.f / QL) + EPS); rs[64 + (tid >> 2)] = rsqrtf(ss1 * (1.f / QL) + EPS); }
    __syncthreads();
    u16* q = (u16*)(p.ws + OFF_QN);
#pragma unroll
    for (int j = 0; j < 4; ++j) {
      const int cb = nt * 256 + (j >> 1) * 128 + wn * 64 + (j & 1) * 32;
      const bool isrope = ((cb >> 5) % 3) == 2;
#pragma unroll
      for (int i = 0; i < 2; ++i) {
        const int ml = wm * 64 + i * 32;
        float v[16];
#pragma unroll
        for (int r = 0; r < 16; ++r) {
          const int mrow = ml + crow(r, hi), m = m0 + mrow;
          v[r] = acc[i][j][r] * rs[mrow];
          if (isrope && lat) v[r] = rope_apply(v[r], r32, m & 4095, rc);
        }
        store_tile_bf16(q + (long)(m0 + ml) * 1536 + cb, 1536, v, r32, hi);
      }
    }
    __syncthreads();
  } else if (EPI == EPI_KVUP) {
    const u16* A = (const u16*)(p.ws + OFF_CKV) + (long)m0 * KVL;
    const u16* B0 = Wt + WUKV_O + (long)(nt * 256) * KVL;
    kloop_dma<true, true, true>(acc, A, KVL, KVL, B0, B0 + 128 * KVL, KVL, As, &ss0, &ss1);
    ss0 += __shfl_xor(ss0, 1); ss0 += __shfl_xor(ss0, 2); ss1 += __shfl_xor(ss1, 1); ss1 += __shfl_xor(ss1, 2);
    if ((tid & 3) == 0) { rs[tid >> 2] = rsqrtf(ss0 * (1.f / KVL) + EPS); rs[64 + (tid >> 2)] = rsqrtf(ss1 * (1.f / KVL) + EPS); }
    __syncthreads();
    u16* kn = (u16*)(p.ws + OFF_KN); u16* vT = (u16*)(p.ws + OFF_VT);
    const int bb = lat ? b : ((m0 - RL) >> 8);
    const int key0 = lat ? (m0 & 4095) : (4096 + ((m0 - RL) & 255));
#pragma unroll
    for (int j = 0; j < 4; ++j) {
      const int cb = nt * 256 + (j >> 1) * 128 + wn * 64 + (j & 1) * 32;
      const int h = cb >> 7, sub = (cb >> 5) & 3;
#pragma unroll
      for (int i = 0; i < 2; ++i) {
        const int ml = wm * 64 + i * 32;
        if (sub < 2) {
          float v[16];
#pragma unroll
          for (int r = 0; r < 16; ++r) v[r] = acc[i][j][r] * rs[ml + crow(r, hi)];
          store_tile_bf16(kn + (long)(m0 + ml) * 1024 + h * 64 + sub * 32, 1024, v, r32, hi);
        } else {
          const int dim = (sub - 2) * 32 + r32;
          u16* dst = vT + ((long)(bb * NH + h) * 64 + dim) * KEYS + key0 + ml;
#pragma unroll
          for (int g = 0; g < 4; ++g) {
            const int mr = 8 * g + 4 * hi;
            const u32x2 v = {pack2(acc[i][j][4 * g] * rs[ml + mr], acc[i][j][4 * g + 1] * rs[ml + mr + 1]),
                             pack2(acc[i][j][4 * g + 2] * rs[ml + mr + 2], acc[i][j][4 * g + 3] * rs[ml + mr + 3])};
            *(u32x2*)(dst + mr) = v;
          }
        }
      }
    }
    __syncthreads();
  } else if (EPI == EPI_G1 || EPI == EPI_G2) {
    const int n0 = nt * 128;
    {
      const u16* A1 = (const u16*)(p.ws + OFF_UT) + (long)1024 * MT + m0;
      const u16* Bp = Wt + WHY_O + (long)n0 * 512;
      kloop<true, false, true, false>(acc, A1, MT, 512, Bp, Bp, 512, As, Bs, ss0, ss1);
    }
    {
      const u16* A1 = (const u16*)(p.ws + OFF_UT) + (long)m0 * 1024;
      const u16* Bp = Wt + WMLA_O + (long)n0 * 1024;
      kloop_dma<false, true>(acc, A1, 1024, 1024, Bp, Bp, 1024, As);
    }
    const unsigned char* g8 = (const unsigned char*)(p.ws + OFF_G8);
    u16* mo = (u16*)(p.ws + OFF_VT);
#pragma unroll
    for (int j = 0; j < 2; ++j) {
      const int col = n0 + wn * 64 + j * 32 + r32;
#pragma unroll
      for (int i = 0; i < 2; ++i) {
        const int mb = m0 + wm * 64 + i * 32 + 4 * hi;
        float v[16];
#pragma unroll
        for (int g = 0; g < 4; ++g) {
          const unsigned gh = *(const unsigned*)(g8 + (long)col * MT + mb + 8 * g);
          const unsigned ga = *(const unsigned*)(g8 + (long)(1024 + col) * MT + mb + 8 * g);
#pragma unroll
          for (int e = 0; e < 4; ++e) {
            const float fh = (float)((gh >> (8 * e)) & 255u) * (1.f / 255.f), fa = (float)((ga >> (8 * e)) & 255u) * (1.f / 255.f);
            v[4 * g + e] = fh * acc[i][j][4 * g + e] + fa * acc[i][2 + j][4 * g + e];
          }
        }
        store_tile_bf16(mo + (long)(m0 + wm * 64 + i * 32) * 1024 + n0 + wn * 64 + j * 32, 1024, v, r32, hi);
      }
    }
  } else if (EPI == EPI_RES) {
    const int n0 = nt * 256;
    if (resid_which == 0) {
      const int Ks = ksl < 0 ? 1024 : 128, k0 = ksl < 0 ? 0 : ksl * 128;
      const u16* A = (const u16*)(p.ws + OFF_VT) + (long)m0 * 1024 + k0;
      const u16* B0 = Wt + WOUT_O + (long)n0 * 1024 + k0;
      kloop_dma<true, true>(acc, A, 1024, Ks, B0, B0 + 128 * 1024, 1024, As);
    } else {
      const int Ks = ksl < 0 ? DFF : DFF / 8, k0 = ksl < 0 ? 0 : ksl * (DFF / 8);
      const u16* A = (const u16*)(p.ws + OFF_KN) + (long)m0 * DFF + k0;
      const u16* B0 = Wt + WFOUT_O + (long)n0 * DFF + k0;
      kloop_dma<true, true>(acc, A, DFF, Ks, B0, B0 + 128 * DFF, DFF, As);
    }
    const float* gate = mod + (resid_which ? 5 : 2) * 1024;
    const bool first = (layer == 0 && resid_which == 0);
    const float* hold; float* hnew; long rbase;
    if (lat) { hold = first ? p.in[0] : p.out; hnew = p.out; rbase = m0; }
    else { hold = (const float*)(p.ws + OFF_HC); hnew = (float*)(p.ws + OFF_HC); rbase = m0 - RL; }
    const bool odd = r32 & 1;
#pragma unroll
    for (int j = 0; j < 4; ++j) {
      const int col = n0 + (j >> 1) * 128 + wn * 64 + (j & 1) * 32 + r32;
      const float gv = gate[col];
#pragma unroll
      for (int i = 0; i < 2; ++i) {
        if (ksl < 0) {
#pragma unroll
          for (int rp = 0; rp < 8; ++rp) {
            const float sa = gv * acc[i][j][2 * rp], sb = gv * acc[i][j][2 * rp + 1];
            const float recv = dpp_swap1(odd ? sa : sb);
            const int row = ((2 * rp) & 3) + 8 * ((2 * rp) >> 2) + 4 * hi + (odd ? 1 : 0);
            const long idx = (rbase + wm * 64 + i * 32 + row) * 1024 + (col & ~1);
            const f32x2 h = *(const f32x2*)(hold + idx);
            *(f32x2*)(hnew + idx) = odd ? (f32x2){h[0] + recv, h[1] + sb} : (f32x2){h[0] + sa, h[1] + recv};
          }
        } else {
#pragma unroll
          for (int r = 0; r < 16; ++r) {
            const long idx = (rbase + wm * 64 + i * 32 + crow(r, hi)) * 1024 + col;
            atomicAdd(hnew + idx, gv * acc[i][j][r]);
          }
        }
      }
    }
  } else if (EPI == EPI_FFNIN) {
    const int n0 = nt * 128;
    const u16* A = (const u16*)(p.ws + OFF_A) + (long)m0 * 1024;
    const u16* B0 = Wt + WFIN_O + (long)n0 * 1024;
    kloop_dma<true, true>(acc, A, 1024, 1024, B0, B0 + (long)DFF * 1024, 1024, As);
    u16* act = (u16*)(p.ws + OFF_KN);
#pragma unroll
    for (int j = 0; j < 2; ++j) {
#pragma unroll
      for (int i = 0; i < 2; ++i) {
        float v[16];
#pragma unroll
        for (int r = 0; r < 16; ++r) { const float gte = acc[i][j][r], u = acc[i][2 + j][r]; v[r] = gte * sigmoidf_(gte) * u; }
        store_tile_bf16(act + (long)(m0 + wm * 64 + i * 32) * DFF + n0 + wn * 64 + j * 32, DFF, v, r32, hi);
      }
    }
  }
}

constexpr int KLD = 104, VLD = 72;
DI void attn_item(const Params& p, bool ctxq, int b, int h, int qb, char* smem) {
  constexpr int ABUF = 64 * KLD + 64 * VLD;
  u16* Ks0 = (u16*)smem; float* wsc = (float*)(Ks0 + 3 * ABUF);
  const int tid = otid(), lane = tid & 63, wave = tid >> 6, r32 = lane & 31, hi = lane >> 5;
  float* al = wsc + wave * 128;
  const u16* q = (const u16*)(p.ws + OFF_QN); const u16* kn = (const u16*)(p.ws + OFF_KN); const u16* kr = (const u16*)(p.ws + OFF_KR);
  const u16* vT = (const u16*)(p.ws + OFF_VT) + (long)(b * NH + h) * 64 * KEYS;
  u16* att = (u16*)(p.ws + OFF_UT);
  const long mq0 = ctxq ? (RL + b * 256) : ((long)b * 4096 + qb * 256);
  const int kt0 = ctxq ? 64 : 0, kt1 = 68;
  bf16x8 qf[2][6];
#pragma unroll
  for (int rb = 0; rb < 2; ++rb) {
    const u16* qp = q + (mq0 + wave * 64 + rb * 32 + r32) * 1536 + h * 96 + hi * 8;
#pragma unroll
    for (int d0 = 0; d0 < 6; ++d0) qf[rb][d0] = *(const bf16x8*)(qp + d0 * 16);
  }
  f32x16 o[2][2];
#pragma unroll
  for (int rb = 0; rb < 2; ++rb)
#pragma unroll
    for (int d = 0; d < 2; ++d)
#pragma unroll
      for (int r = 0; r < 16; ++r) o[rb][d][r] = 0.f;
  float m_run[2] = {-1e30f, -1e30f}, l_run[2] = {0.f, 0.f};
  constexpr float C = 0.10206207261596577f * 1.4426950408889634f;
  u16* dump = (u16*)(wsc + 512);
  const u16* gk[4]; int kpitch[4]; const u16* gv[3];
  const long mk00 = ctxq ? (RL + b * 256) : ((long)b * 4096);
#pragma unroll
  for (int i = 0; i < 4; ++i) {
    const int slot = wave + 4 * i, c = slot * 64 + lane;
    const bool real = slot < 13;
    int row = c / 13, part = c - row * 13;
    if (!real) { row = 0; part = 0; }
    if (part == 12) part = 0;
    if (part < 8) { gk[i] = kn + (mk00 + row) * 1024 + h * 64 + part * 8; kpitch[i] = 1024; }
    else { gk[i] = kr + (mk00 + row) * 32 + (part - 8) * 8; kpitch[i] = 32; }
  }
#pragma unroll
  for (int i = 0; i < 3; ++i) {
    const int slot = wave + 4 * i, c = slot * 64 + lane;
    const bool real = slot < 9;
    int dim = c / 9, part = c - dim * 9;
    if (!real) { dim = 0; part = 0; }
    if (part == 8) part = 0;
    gv[i] = vT + (long)dim * KEYS + kt0 * 64 + part * 8;
  }
  const int ctxjump = ctxq ? 0 : (RL + b * 256) - (b * 4096 + 4096);
#define AISSUE(j, bsel)                                                                                    \
  do {                                                                                                     \
    const int rowofs = 64 * (j) + ((kt0 + (j)) >= 64 ? ctxjump : 0);                                       \
    u16* KsD = Ks0 + (bsel) * ABUF; u16* VsD = KsD + 64 * KLD;                                             \
    _Pragma("unroll") for (int i = 0; i < 4; ++i) {                                                        \
      const int slot = wave + 4 * i;                                                                       \
      glds16(gk[i] + (long)rowofs * kpitch[i], slot < 13 ? KsD + slot * 512 : dump);                       \
    }                                                                                                      \
    _Pragma("unroll") for (int i = 0; i < 3; ++i) {                                                        \
      const int slot = wave + 4 * i;                                                                       \
      glds16(gv[i] + 64 * (j), slot < 9 ? VsD + slot * 512 : dump);                                        \
    }                                                                                                      \
  } while (0)
  const int n = kt1 - kt0;
  asm volatile("s_waitcnt vmcnt(0)" ::: "memory");
  __syncthreads();
  AISSUE(0, 0);
  AISSUE(1, 1);
  int buf = 0;
#pragma unroll 1
  for (int j = 0; j < n; ++j) {
    if (j + 1 < n) asm volatile("s_waitcnt vmcnt(7)" ::: "memory"); else asm volatile("s_waitcnt vmcnt(0)" ::: "memory");
    asm volatile("s_waitcnt lgkmcnt(0)" ::: "memory");
    __builtin_amdgcn_s_barrier();
    asm volatile("" ::: "memory");
    if (j + 2 < n) { const int nb = buf == 0 ? 2 : buf - 1; AISSUE(j + 2, nb); }
    const u16* Ks = Ks0 + buf * ABUF; const u16* Vs = Ks + 64 * KLD;
    buf = buf == 2 ? 0 : buf + 1;
    f32x16 pp[2][2];
#pragma unroll
    for (int rb = 0; rb < 2; ++rb)
#pragma unroll
      for (int kb = 0; kb < 2; ++kb)
#pragma unroll
        for (int r = 0; r < 16; ++r) pp[rb][kb][r] = 0.f;
#pragma unroll
    for (int d0 = 0; d0 < 6; ++d0) {
#pragma unroll
      for (int kb = 0; kb < 2; ++kb) {
        const bf16x8 kf = *(const bf16x8*)(Ks + (kb * 32 + r32) * KLD + d0 * 16 + hi * 8);
        pp[0][kb] = MFMA32(kf, qf[0][d0], pp[0][kb]);
        pp[1][kb] = MFMA32(kf, qf[1][d0], pp[1][kb]);
      }
    }
    constexpr float THRS = 8.f / 0.10206207261596577f;
    float pmx[2];
#pragma unroll
    for (int rb = 0; rb < 2; ++rb) {
      float pmax = pp[rb][0][0];
#pragma unroll
      for (int r = 1; r < 16; ++r) pmax = fmaxf(pmax, pp[rb][0][r]);
#pragma unroll
      for (int r = 0; r < 16; ++r) pmax = fmaxf(pmax, pp[rb][1][r]);
      pmx[rb] = fmaxf(pmax, __shfl_xor(pmax, 32));
    }
    const bool keep = __all((pmx[0] - m_run[0] <= THRS) && (pmx[1] - m_run[1] <= THRS));
    float alpha[2] = {1.f, 1.f};
    if (!keep) {
#pragma unroll
      for (int rb = 0; rb < 2; ++rb) {
        const float m_new = fmaxf(m_run[rb], pmx[rb]);
        alpha[rb] = __builtin_amdgcn_exp2f((m_run[rb] - m_new) * C);
        m_run[rb] = m_new;
      }
    }
#pragma unroll
    for (int rb = 0; rb < 2; ++rb) {
      const float mc = -m_run[rb] * C;
      const f32x2 C2 = {C, C}, mc2 = {mc, mc};
      f32x2 ps2 = {0.f, 0.f};
#pragma unroll
      for (int kb = 0; kb < 2; ++kb)
#pragma unroll
        for (int r = 0; r < 16; r += 2) {
          const f32x2 t = __builtin_elementwise_fma((f32x2){pp[rb][kb][r], pp[rb][kb][r + 1]}, C2, mc2);
          const f32x2 e = {__builtin_amdgcn_exp2f(t[0]), __builtin_amdgcn_exp2f(t[1])};
          pp[rb][kb][r] = e[0]; pp[rb][kb][r + 1] = e[1];
          ps2 += e;
        }
      float psum = ps2[0] + ps2[1];
      psum += __shfl_xor(psum, 32);
      l_run[rb] = l_run[rb] * alpha[rb] + psum;
    }
    if (!keep) {
      if (hi == 0) { al[r32] = alpha[0]; al[32 + r32] = alpha[1]; }
      asm volatile("s_waitcnt lgkmcnt(0)" ::: "memory");
#pragma unroll
      for (int rb = 0; rb < 2; ++rb)
#pragma unroll
        for (int r = 0; r < 16; ++r) { const float a = al[rb * 32 + crow(r, hi)]; o[rb][0][r] *= a; o[rb][1][r] *= a; }
    }
#pragma unroll
    for (int s = 0; s < 4; ++s) {
      const int kb = s >> 1, rbs = (s & 1) * 8;
      bf16x8 pa[2];
#pragma unroll
      for (int rb = 0; rb < 2; ++rb) {
        const u32x4 pw = {pack2(pp[rb][kb][rbs], pp[rb][kb][rbs + 1]), pack2(pp[rb][kb][rbs + 2], pp[rb][kb][rbs + 3]),
                          pack2(pp[rb][kb][rbs + 4], pp[rb][kb][rbs + 5]), pack2(pp[rb][kb][rbs + 6], pp[rb][kb][rbs + 7])};
        pa[rb] = __builtin_bit_cast(bf16x8, pw);
      }
#pragma unroll
      for (int d = 0; d < 2; ++d) {
        const u16* vp = Vs + (d * 32 + r32) * VLD + 16 * s + 4 * hi;
        const u32x2 v0 = *(const u32x2*)vp, v1 = *(const u32x2*)(vp + 8);
        const u32x4 vw = {v0[0], v0[1], v1[0], v1[1]};
        const bf16x8 vf = __builtin_bit_cast(bf16x8, vw);
        o[0][d] = MFMA32(pa[0], vf, o[0][d]);
        o[1][d] = MFMA32(pa[1], vf, o[1][d]);
      }
    }
  }
#undef AISSUE
  asm volatile("s_waitcnt lgkmcnt(0)" ::: "memory");
  if (hi == 0) { al[64 + r32] = l_run[0]; al[96 + r32] = l_run[1]; }
  asm volatile("s_waitcnt lgkmcnt(0)" ::: "memory");
#pragma unroll
  for (int rb = 0; rb < 2; ++rb) {
    float il[16];
#pragma unroll
    for (int r = 0; r < 16; ++r) il[r] = __builtin_amdgcn_rcpf(al[64 + rb * 32 + crow(r, hi)]);
#pragma unroll
    for (int d = 0; d < 2; ++d) {
      float v[16];
#pragma unroll
      for (int r = 0; r < 16; ++r) v[r] = o[rb][d][r] * il[r];
      store_tile_bf16(att + (mq0 + wave * 64 + rb * 32) * 1024 + h * 64 + d * 32, 1024, v, r32, hi);
    }
  }
  __syncthreads();
}

constexpr float HY_MIN_DECAY = -3.0701134573253943f, HY_MAX_DECAY = -15.350567286626972f;
DI int phys(int i) { return i + (i >> 4); }
DI unsigned packh2(float a, float b) { f32x2 v = {a, b}; f16x2_t h = __builtin_convertvector(v, f16x2_t); return __builtin_bit_cast(unsigned, h); }
DI f32x2 unpackh2(unsigned u) { f16x2_t h = __builtin_bit_cast(f16x2_t, u); return __builtin_convertvector(h, f32x2); }
DI float opaque(float x) { asm volatile("" : "+v"(x)); return x; }
DI constexpr int brev4(int p) { return ((p & 1) << 3) | ((p & 2) << 1) | ((p & 4) >> 1) | ((p & 8) >> 3); }

DI f32x2 cmul(f32x2 a, f32x2 w) { return (f32x2){a[0] * w[0] - a[1] * w[1], a[0] * w[1] + a[1] * w[0]}; }
template <bool INV, int S>
DI void dft16_stage(f32x2 (&a)[16]) {
  constexpr float C16[8] = {1.f, 0.92387953251128674f, 0.70710678118654752f, 0.38268343236508977f, 0.f, -0.38268343236508977f, -0.70710678118654752f, -0.92387953251128674f};
  constexpr float S16[8] = {0.f, 0.38268343236508977f, 0.70710678118654752f, 0.92387953251128674f, 1.f, 0.92387953251128674f, 0.70710678118654752f, 0.38268343236508977f};
#pragma unroll
  for (int i = 0; i < 16; ++i) {
    if ((i & S) == 0) {
      const int j = i & (S - 1), tw = j * (8 / S);
      const f32x2 u = a[i], v = a[i + S];
      a[i] = u + v;
      const f32x2 d = u - v;
      if (tw == 0) a[i + S] = d;
      else if (tw == 4) a[i + S] = INV ? (f32x2){-d[1], d[0]} : (f32x2){d[1], -d[0]};
      else a[i + S] = cmul(d, (f32x2){C16[tw], INV ? S16[tw] : -S16[tw]});
    }
  }
}
template <bool INV>
DI void dft16(f32x2 (&a)[16]) { dft16_stage<INV, 8>(a); dft16_stage<INV, 4>(a); dft16_stage<INV, 2>(a); dft16_stage<INV, 1>(a); }

template <int S>
DI void idft16_dit_stage(f32x2 (&a)[16]) {
  constexpr float C16[8] = {1.f, 0.92387953251128674f, 0.70710678118654752f, 0.38268343236508977f, 0.f, -0.38268343236508977f, -0.70710678118654752f, -0.92387953251128674f};
  constexpr float S16[8] = {0.f, 0.38268343236508977f, 0.70710678118654752f, 0.92387953251128674f, 1.f, 0.92387953251128674f, 0.70710678118654752f, 0.38268343236508977f};
#pragma unroll
  for (int i = 0; i < 16; ++i) {
    if ((i & S) == 0) {
      const int j = i & (S - 1), tw = j * (8 / S);
      const f32x2 u = a[i];
      f32x2 v = a[i + S];
      if (tw == 4) v = (f32x2){-v[1], v[0]};
      else if (tw != 0) v = cmul(v, (f32x2){C16[tw], S16[tw]});
      a[i] = u + v; a[i + S] = u - v;
    }
  }
}
DI void idft16_dit(f32x2 (&a)[16]) { idft16_dit_stage<1>(a); idft16_dit_stage<2>(a); idft16_dit_stage<4>(a); idft16_dit_stage<8>(a); }

template <int NSUB, bool INV>
DI void fft_pass(f32x2* x) {
  constexpr int m = NSUB / 16;
  const int tid = otid();
  const int j = tid % m;
  f32x2 w[9];
  {
    const float fr = opaque((float)j / (float)NSUB);
    const float c1 = __builtin_amdgcn_cosf(fr), s1 = __builtin_amdgcn_sinf(fr);
    w[0] = (f32x2){1.f, 0.f}; w[1] = (f32x2){c1, INV ? s1 : -s1};
    w[2] = cmul(w[1], w[1]); w[3] = cmul(w[2], w[1]); w[4] = cmul(w[2], w[2]); w[5] = cmul(w[4], w[1]);
    w[6] = cmul(w[4], w[2]); w[7] = cmul(w[4], w[3]); w[8] = cmul(w[4], w[4]);
  }
#pragma unroll
  for (int gi = 0; gi < 2; ++gi) {
    const int g = tid + 256 * gi, b0 = (g / m) * NSUB;
    f32x2 a[16];
    if (!INV) {
#pragma unroll
      for (int q = 0; q < 16; ++q) a[q] = x[phys(b0 + j + q * m)];
      dft16<false>(a);
#pragma unroll
      for (int pp = 0; pp < 16; ++pp) {
        const int r = brev4(pp);
        const f32x2 t = r < 8 ? w[r] : cmul(w[r - 8], w[8]);
        x[phys(b0 + r * m + j)] = cmul(a[pp], t);
      }
    } else {
#pragma unroll
      for (int r = 0; r < 16; ++r) {
        const f32x2 t = r < 8 ? w[r] : cmul(w[r - 8], w[8]);
        a[r] = cmul(x[phys(b0 + r * m + j)], t);
      }
      dft16<true>(a);
#pragma unroll
      for (int pp = 0; pp < 16; ++pp) { const int q = brev4(pp); x[phys(b0 + j + q * m)] = a[pp]; }
    }
  }
}

DI float sconv(const u16* row, long seg, int i, int L, float w0, float w1, float w2, float bb) {
  const float um = i > 0 ? bf2f(row[seg + i - 1]) : 0.f, u0 = bf2f(row[seg + i]), up = i < L - 1 ? bf2f(row[seg + i + 1]) : 0.f;
  return w0 * um + w1 * u0 + w2 * up + bb;
}

DI void hyena_lat_item(const Params& p, int layer, int w, char* smem) {
  f32x2* x = (f32x2*)smem;
  float* sc = (float*)(smem + 8704 * 8);
  const int tid = otid();
  u16* uT = (u16*)(p.ws + OFF_UT);
  u16* vrow = uT + (long)(1024 + w) * MT;
  const float* h2 = (const float*)(p.ws + OFF_H2) + (long)layer * 4096 * 64;
  const float* w3 = p.in[16] + (long)layer * 64 * 2048;
  const float* cw = p.in[10] + layer * 3 * 1536, *cb = p.in[11] + layer * 1536;
  const float absd = -(HY_MIN_DECAY + (float)w * ((HY_MAX_DECAY - HY_MIN_DECAY) / 511.f));
  {
#pragma unroll 1
    for (int rsel = 0; rsel < 3; ++rsel) {
      const int ch = rsel * 512 + w;
      u16* row = uT + (long)ch * MT;
      const float w0 = cw[ch], w1 = cw[1536 + ch], w2 = cw[3072 + ch], bb = cb[ch];
#pragma unroll 1
      for (int g4 = 0; g4 < 1; ++g4) {
        u32x4 o0[8], o1[8];
        const int t16 = otid() * 16;
#pragma unroll
        for (int q = 0; q < 8; ++q) {
          const u16* seg = row + (long)q * 4096 + t16;
          const u32x4 r0 = *(const u32x4*)seg, r1 = *(const u32x4*)(seg + 8);
          const float hl = t16 > 0 ? bf2f(seg[-1]) : 0.f, hr = t16 < 4080 ? bf2f(seg[16]) : 0.f;
          float u[18];
          u[0] = hl; u[17] = hr;
#pragma unroll
          for (int e = 0; e < 4; ++e) {
            u[1 + 2 * e] = __uint_as_float(r0[e] << 16); u[2 + 2 * e] = __uint_as_float(r0[e] & 0xffff0000u);
            u[9 + 2 * e] = __uint_as_float(r1[e] << 16); u[10 + 2 * e] = __uint_as_float(r1[e] & 0xffff0000u);
          }
          float y[16];
#pragma unroll
          for (int e = 0; e < 16; ++e) y[e] = w0 * u[e] + w1 * u[e + 1] + w2 * u[e + 2] + bb;
          o0[q] = (u32x4){pack2(y[0], y[1]), pack2(y[2], y[3]), pack2(y[4], y[5]), pack2(y[6], y[7])};
          o1[q] = (u32x4){pack2(y[8], y[9]), pack2(y[10], y[11]), pack2(y[12], y[13]), pack2(y[14], y[15])};
        }
        asm volatile("s_waitcnt vmcnt(0)" ::: "memory");
        __syncthreads();
#pragma unroll
        for (int q = 0; q < 8; ++q) {
          u16* seg = row + (long)q * 4096 + t16;
          *(u32x4*)seg = o0[q]; *(u32x4*)(seg + 8) = o1[q];
        }
      }
    }
    __syncthreads();
  }
  unsigned Hp[2][16];
#pragma unroll 1
  for (int o = 0; o < 2; ++o) {
    const u16* grow = uT + (long)(o * 512 + w) * MT;
    const float bias = p.in[18][(layer * 2 + o) * 512 + w];
    __syncthreads();
    if (tid < 64) sc[16 + tid] = w3[tid * 2048 + o * 512 + w];
    else if (tid < 128) sc[80 + tid - 64] = w3[(tid - 64) * 2048 + 1024 + o * 512 + w];
    __syncthreads();
    float asum = 0.f;
#pragma unroll 4
    for (int k = 0; k < 16; ++k) {
      const int jj = otid() + 256 * k;
      const f32x4* hr = (const f32x4*)(h2 + (long)jj * 64);
      float df = 0.f, db = 0.f;
      int zoff = 0; asm volatile("" : "+v"(zoff));
      const f32x4* scf = (const f32x4*)(sc + 16 + zoff);
#pragma unroll
      for (int q4 = 0; q4 < 16; ++q4) {
        const f32x4 hv = hr[q4], wf = scf[q4], wb = scf[16 + q4];
        df += hv[0] * wf[0] + hv[1] * wf[1] + hv[2] * wf[2] + hv[3] * wf[3];
        db += hv[0] * wb[0] + hv[1] * wb[1] + hv[2] * wb[2] + hv[3] * wb[3];
      }
      const float win = __expf(-((float)jj * (1.f / 4095.f)) * absd);
      const float f = df * win, bk = db * win;
      asum += fabsf(f) + (jj > 0 ? fabsf(bk) : 0.f);
      x[phys(4096 + jj)] = (f32x2){f, bk};
    }
    asum = wave_sum(asum);
    if ((tid & 63) == 0) sc[tid >> 6] = asum;
    __syncthreads();
    const float norm = sc[0] + sc[1] + sc[2] + sc[3];
    {
      float a0[16], a1[16];
#pragma unroll
      for (int k = 0; k < 16; ++k) {
        const int i = otid() + 256 * k;
        a0[k] = x[phys(4096 + i)][0];
        a1[k] = i == 0 ? 0.f : x[phys(8192 - i)][1];
      }
      __syncthreads();
#pragma unroll
      for (int k = 0; k < 16; ++k) {
        const int i = otid() + 256 * k;
        const float fr = opaque((float)i * (1.f / 8192.f));
        const float c = __builtin_amdgcn_cosf(fr), s = __builtin_amdgcn_sinf(fr);
        const float d = a0[k] - a1[k];
        x[phys(i)] = (f32x2){a0[k] + a1[k], 0.f};
        x[phys(4096 + i)] = (f32x2){d * c, -d * s};
      }
    }
    __syncthreads();
    fft_pass<4096, false>(x); __syncthreads();
    fft_pass<256, false>(x); __syncthreads();
    {
      const float scale = 1.f / norm;
#pragma unroll
      for (int gi = 0; gi < 2; ++gi) {
        const int g = otid() + 256 * gi, b0 = g * 16;
        f32x2 a[16];
#pragma unroll
        for (int q = 0; q < 16; ++q) a[q] = x[b0 + q + g];
        dft16<false>(a);
#pragma unroll
        for (int q = 0; q < 16; ++q) Hp[gi][q] = packh2(a[q][0] * scale, a[q][1] * scale);
        __builtin_amdgcn_sched_barrier(0);
      }
    }
    __syncthreads();
#pragma unroll 1
    for (int pr = 0; pr < 4; ++pr) {
      const long s0 = (long)(2 * pr) * 4096, s1 = s0 + 4096;
      {
        const int tt = otid();
        const u16* pv0 = vrow + s0 + tt * 16; const u16* pv1 = vrow + s1 + tt * 16;
        const u32x4 a0 = *(const u32x4*)pv0, a1 = *(const u32x4*)(pv0 + 8), b0v = *(const u32x4*)pv1, b1v = *(const u32x4*)(pv1 + 8);
        const float fr = opaque((float)(tt * 16) * (1.f / 8192.f));
        f32x2 wq = {__builtin_amdgcn_cosf(fr), -__builtin_amdgcn_sinf(fr)};
        const f32x2 dw = {0.99999970588366f, -7.6699031874270e-4f};
        f32x2* xl = x + tt * 17; f32x2* xh = x + 4352 + tt * 17;
#pragma unroll
        for (int k = 0; k < 16; ++k) {
          const unsigned ua = k < 8 ? a0[k >> 1] : a1[(k - 8) >> 1], ub = k < 8 ? b0v[k >> 1] : b1v[(k - 8) >> 1];
          const float re = (k & 1) ? __uint_as_float(ua & 0xffff0000u) : __uint_as_float(ua << 16);
          const float im = (k & 1) ? __uint_as_float(ub & 0xffff0000u) : __uint_as_float(ub << 16);
          const f32x2 z = {re, im};
          xl[k] = z; xh[k] = cmul(z, wq);
          wq = cmul(wq, dw);
        }
      }
      __syncthreads();
      fft_pass<4096, false>(x); __syncthreads();
      fft_pass<256, false>(x); __syncthreads();
#pragma unroll
      for (int gi = 0; gi < 2; ++gi) {
        const int g = otid() + 256 * gi, b0 = g * 16;
        f32x2 a[16];
#pragma unroll
        for (int q = 0; q < 16; ++q) a[q] = x[b0 + q + g];
        dft16<false>(a);
#pragma unroll
        for (int pp = 0; pp < 16; ++pp) a[pp] = cmul(a[pp], unpackh2(Hp[gi][pp]));
        idft16_dit(a);
#pragma unroll
        for (int q = 0; q < 16; ++q) x[b0 + q + g] = a[q];
        __builtin_amdgcn_sched_barrier(0);
      }
      __syncthreads();
      fft_pass<256, true>(x); __syncthreads();
      fft_pass<4096, true>(x); __syncthreads();
      {
        const int tt = otid();
        u16* pv0 = vrow + s0 + tt * 16; u16* pv1 = vrow + s1 + tt * 16;
        const u16* pg0 = grow + s0 + tt * 16; const u16* pg1 = grow + s1 + tt * 16;
        const u32x4 a0 = *(const u32x4*)pv0, a1 = *(const u32x4*)(pv0 + 8), b0v = *(const u32x4*)pv1, b1v = *(const u32x4*)(pv1 + 8);
        const u32x4 c0 = *(const u32x4*)pg0, c1 = *(const u32x4*)(pg0 + 8), d0 = *(const u32x4*)pg1, d1 = *(const u32x4*)(pg1 + 8);
        const float fr = opaque((float)(tt * 16) * (1.f / 8192.f));
        f32x2 wq = {__builtin_amdgcn_cosf(fr), __builtin_amdgcn_sinf(fr)};
        const f32x2 dw = {0.99999970588366f, 7.6699031874270e-4f};
        const f32x2* xl = x + tt * 17; const f32x2* xh = x + 4352 + tt * 17;
        float r0[16], r1[16];
#pragma unroll
        for (int k = 0; k < 16; ++k) {
          const f32x2 y = (xl[k] + cmul(xh[k], wq)) * (1.f / 8192.f);
          wq = cmul(wq, dw);
          const unsigned ua = k < 8 ? a0[k >> 1] : a1[(k - 8) >> 1], ub = k < 8 ? b0v[k >> 1] : b1v[(k - 8) >> 1];
          const unsigned uc = k < 8 ? c0[k >> 1] : c1[(k - 8) >> 1], ud = k < 8 ? d0[k >> 1] : d1[(k - 8) >> 1];
          const float v0 = (k & 1) ? __uint_as_float(ua & 0xffff0000u) : __uint_as_float(ua << 16);
          const float v1 = (k & 1) ? __uint_as_float(ub & 0xffff0000u) : __uint_as_float(ub << 16);
          const float g0 = (k & 1) ? __uint_as_float(uc & 0xffff0000u) : __uint_as_float(uc << 16);
          const float g1 = (k & 1) ? __uint_as_float(ud & 0xffff0000u) : __uint_as_float(ud << 16);
          r0[k] = g0 * (y[0] + bias * v0); r1[k] = g1 * (y[1] + bias * v1);
        }
        *(u32x4*)pv0 = (u32x4){pack2(r0[0], r0[1]), pack2(r0[2], r0[3]), pack2(r0[4], r0[5]), pack2(r0[6], r0[7])};
        *(u32x4*)(pv0 + 8) = (u32x4){pack2(r0[8], r0[9]), pack2(r0[10], r0[11]), pack2(r0[12], r0[13]), pack2(r0[14], r0[15])};
        *(u32x4*)pv1 = (u32x4){pack2(r1[0], r1[1]), pack2(r1[2], r1[3]), pack2(r1[4], r1[5]), pack2(r1[6], r1[7])};
        *(u32x4*)(pv1 + 8) = (u32x4){pack2(r1[8], r1[9]), pack2(r1[10], r1[11]), pack2(r1[12], r1[13]), pack2(r1[14], r1[15])};
      }
      __syncthreads();
    }
  }
  __syncthreads();
}

DI void hyena_ctx_item(const Params& p, int w, char* smem) {
  float* F = (float*)smem; float* Bk = F + 256; float* vin = Bk + 256; float* sc = vin + 256;
  const int tid = otid(), t = tid;
  u16* uT = (u16*)(p.ws + OFF_UT);
  u16* vrow = uT + (long)(1024 + w) * MT + RL;
  const float* h2c = (const float*)(p.ws + OFF_H2C);
  const float* w3 = p.in[16];
  const float* cw = p.in[10], *cb = p.in[11];
  const float absd = -(HY_MIN_DECAY + (float)w * ((HY_MAX_DECAY - HY_MIN_DECAY) / 511.f));
  const float vw0 = cw[1024 + w], vw1 = cw[1536 + 1024 + w], vw2 = cw[3072 + 1024 + w], vbb = cb[1024 + w];
  float vv[8];
#pragma unroll
  for (int b = 0; b < 8; ++b) vv[b] = sconv(vrow, (long)b * 256, t, 256, vw0, vw1, vw2, vbb);
#pragma unroll 1
  for (int o = 0; o < 2; ++o) {
    const u16* grow = uT + (long)(o * 512 + w) * MT + RL;
    const float gw0 = cw[o * 512 + w], gw1 = cw[1536 + o * 512 + w], gw2 = cw[3072 + o * 512 + w], gbb = cb[o * 512 + w];
    const float bias = p.in[18][o * 512 + w];
    __syncthreads();
    {
      float df = 0.f, db = 0.f;
      for (int k = 0; k < 64; ++k) { const float hv = h2c[t * 64 + k]; df += hv * w3[k * 2048 + o * 512 + w]; db += hv * w3[k * 2048 + 1024 + o * 512 + w]; }
      const float win = __expf(-((float)t * (1.f / 255.f)) * absd);
      const float f = df * win, bk = db * win;
      F[t] = f; Bk[t] = bk;
      float asum = fabsf(f) + (t > 0 ? fabsf(bk) : 0.f);
      asum = wave_sum(asum);
      if ((tid & 63) == 0) sc[tid >> 6] = asum;
    }
    __syncthreads();
    const float inorm = 1.f / (sc[0] + sc[1] + sc[2] + sc[3]);
#pragma unroll
    for (int b = 0; b < 8; ++b) {
      vin[t] = vv[b];
      __syncthreads();
      float y = 0.f;
      for (int s = 0; s <= t; ++s) y += F[t - s] * vin[s];
      for (int s = t + 1; s < 256; ++s) y += Bk[s - t] * vin[s];
      const float g = sconv(grow, (long)b * 256, t, 256, gw0, gw1, gw2, gbb);
      vv[b] = g * (y * inorm + bias * vv[b]);
      __syncthreads();
    }
  }
#pragma unroll
  for (int b = 0; b < 8; ++b) vrow[(long)b * 256 + t] = f2bf(vv[b]);
  __syncthreads();
}

constexpr int NPHASE = 20;
constexpr int MTILES = MT / 128, LTILES = RL / 128;

DI void run_phase(const Params& pin, int ph, char* smem, int vb, int nvb) {
  Params p = pin;
  asm volatile("" : "+s"(p.ws), "+s"(p.out));
  if (ph == 0) {
    for (int it = vb; it < 4096 + 192 + 2112 + 256 + 256; it += nvb) {
      if (it < 4096) wconv_item(p, 0, it, smem);
      else if (it < 4288) mod_item(p, it - 4096, smem);
      else if (it < 6400) h2_item(p, it - 4288, smem);
      else if (it < 6656) rope_item(p, it - 6400);
      else {
        const f32x4* src = (const f32x4*)p.in[2] + (long)(it - 6656) * 2048; f32x4* dst = (f32x4*)(p.ws + OFF_HC) + (long)(it - 6656) * 2048;
        for (int k = otid(); k < 2048; k += 256) dst[k] = src[k];
      }
    }
    return;
  }
  if (ph == NPHASE - 1) { final_norm(p, vb, nvb); return; }
  const int layer = (ph - 1) / 9, sub = (ph - 1) % 9;
  const int mtl = layer == 0 ? MTILES : LTILES;
#define TILE_LOOP(T, NT, OFFS, CALL)                                                     \
  for (int it_ = vb; it_ < ((T) + nvb - 1) / nvb * nvb; it_ += nvb) {                     \
    const int tl_ = ((it_ / nvb) * 8 + (vb & 7)) * (nvb >> 3) + (vb >> 3);                \
    if (tl_ < (T)) {                                                                      \
      const int sr_ = tl_ / (8 * (NT)), rem_ = tl_ - sr_ * 8 * (NT);                      \
      const int nt = rem_ >> 3, mt = (OFFS) + sr_ * 8 + (rem_ & 7);                       \
      CALL;                                                                               \
    }                                                                                     \
  }
  switch (sub) {
    case 0:
      norm_rows(p, layer, 0, vb, nvb);
      if (layer == 1) for (int it = vb; it < 4096; it += nvb) wconv_item(p, 1, it, smem);
      break;
    case 1: {
      TILE_LOOP(mtl * 17, 17, 0, gemm_tile<EPI_UIN>(p, layer, mt, nt, smem, 0))
      if (layer == 1) for (int e = vb; e < (MTILES - LTILES) * 2; e += nvb) gemm_tile<EPI_UIN>(p, layer, LTILES + (e >> 1), 7 + (e & 1), smem, 0);
    } break;
    case 2: {
      const int nhy = layer == 0 ? 1024 : 512;
      const bool gemm_first = vb >= (nvb >> 1);
#pragma unroll 1
      for (int pass = 0; pass < 2; ++pass) {
        if ((pass == 0) != gemm_first) {
          for (int it = vb; it < nhy; it += nvb) {
            if (it < 512) hyena_lat_item(p, layer, it, smem);
            else hyena_ctx_item(p, it - 512, smem);
          }
        } else {
          TILE_LOOP(mtl * 6, 6, 0, gemm_tile<EPI_QUP>(p, layer, mt, nt, smem, 0))
          TILE_LOOP(MTILES * 8, 8, 0, gemm_tile<EPI_KVUP>(p, layer, mt, nt, smem, 0))
        }
      }
    } break;
    case 3: {
      const int nlat = NBATCH * NH * 16, nctx = layer == 0 ? NBATCH * NH : 0;
      for (int it_ = vb; it_ < (nlat + nvb - 1) / nvb * nvb; it_ += nvb) {
        const int it = ((it_ / nvb) * 8 + (vb & 7)) * (nvb >> 3) + (vb >> 3);
        if (it < nlat) attn_item(p, false, it >> 8, (it >> 4) & 15, it & 15, smem);
      }
      for (int e = vb; e < nctx; e += nvb) attn_item(p, true, e >> 4, e & 15, 0, smem);
    } break;
    case 4: TILE_LOOP(mtl * 8, 8, 0, gemm_tile<EPI_G1>(p, layer, mt, nt, smem, 0)) break;
    case 5:
      TILE_LOOP(LTILES * 4, 4, 0, gemm_tile<EPI_RES>(p, layer, mt, nt, smem, 0))
      if (layer == 0) for (int e = vb; e < (MTILES - LTILES) * 4 * 8; e += nvb) gemm_tile<EPI_RES>(p, layer, LTILES + (e >> 5), (e >> 3) & 3, smem, 0, e & 7);
      break;
    case 6: norm_rows(p, layer, 1, vb, nvb); break;
    case 7: TILE_LOOP(mtl * 22, 22, 0, gemm_tile<EPI_FFNIN>(p, layer, mt, nt, smem, 0)) break;
    case 8:
      TILE_LOOP(LTILES * 4, 4, 0, gemm_tile<EPI_RES>(p, layer, mt, nt, smem, 1))
      if (layer == 0) for (int e = vb; e < (MTILES - LTILES) * 4 * 8; e += nvb) gemm_tile<EPI_RES>(p, layer, LTILES + (e >> 5), (e >> 3) & 3, smem, 1, e & 7);
      break;
  }
#undef TILE_LOOP
}

DI void fast_grid_sync(unsigned* ctr, unsigned target) {
  asm volatile("s_waitcnt vmcnt(0)" ::: "memory");
  __syncthreads();
  if (threadIdx.x == 0) {
    __builtin_amdgcn_fence(__ATOMIC_RELEASE, "agent");
    asm volatile("s_waitcnt vmcnt(0)" ::: "memory");
    __hip_atomic_fetch_add(ctr, 1u, __ATOMIC_RELAXED, __HIP_MEMORY_SCOPE_AGENT);
    while (__hip_atomic_load(ctr, __ATOMIC_RELAXED, __HIP_MEMORY_SCOPE_AGENT) < target) __builtin_amdgcn_s_sleep(8);
    __builtin_amdgcn_fence(__ATOMIC_ACQUIRE, "agent");
    asm volatile("s_waitcnt vmcnt(0)" ::: "memory");
  }
  __syncthreads();
}

__global__ void __launch_bounds__(NTHREADS, 2) mega_kernel(Params p) {
  extern __shared__ __attribute__((aligned(16))) char smem[];
  cg::grid_group grid = cg::this_grid();
  for (int ph = 0; ph < NPHASE; ++ph) {
    run_phase(p, ph, smem, blockIdx.x, gridDim.x);
    if (ph == 0) {
      if (blockIdx.x == 0 && threadIdx.x == 0) __hip_atomic_store((unsigned*)(p.ws + OFF_BAR), 0u, __ATOMIC_RELAXED, __HIP_MEMORY_SCOPE_AGENT);
      grid.sync();
    } else if (ph + 1 < NPHASE) {
      fast_grid_sync((unsigned*)(p.ws + OFF_BAR), (unsigned)ph * gridDim.x);
    }
  }
}

#if MULTI_LAUNCH
__global__ void __launch_bounds__(NTHREADS, 2) phase_kernel(Params p, int ph) {
  extern __shared__ __attribute__((aligned(16))) char smem[];
  run_phase(p, ph, smem, blockIdx.x, gridDim.x);
}
#endif

extern "C" void kernel_launch(void* const* d_in, const int* in_sizes, int n_in, void* d_out, int out_size, void* d_ws, size_t ws_size,
                              hipStream_t stream) {
  static int grid_blocks = 0;
  if (!grid_blocks) {
    int dev = 0, cus = 0, per_cu = 0;
    (void)hipGetDevice(&dev);
    (void)hipDeviceGetAttribute(&cus, hipDeviceAttributeMultiprocessorCount, dev);
    (void)hipFuncSetAttribute((const void*)mega_kernel, hipFuncAttributeMaxDynamicSharedMemorySize, LDS_BYTES);
#if MULTI_LAUNCH
    (void)hipFuncSetAttribute((const void*)phase_kernel, hipFuncAttributeMaxDynamicSharedMemorySize, LDS_BYTES);
#endif
    (void)hipOccupancyMaxActiveBlocksPerMultiprocessor(&per_cu, mega_kernel, NTHREADS, LDS_BYTES);
    if (per_cu < 1) per_cu = 1;
    if (per_cu > 2) per_cu = 2;
    grid_blocks = cus * per_cu;
  }
  Params p{};
  for (int i = 0; i < 29; ++i) p.in[i] = (const float*)d_in[i];
  p.out = (float*)d_out;
  p.ws = (char*)d_ws;
  if (ws_size < WS_END + 256) { fprintf(stderr, "workspace too small\n"); return; }
#if MULTI_LAUNCH
  for (int ph = 0; ph < NPHASE; ++ph) hipLaunchKernelGGL(phase_kernel, dim3(grid_blocks), dim3(NTHREADS), LDS_BYTES, stream, p, ph);
#else
  void* args[] = {&p};
  hipError_t e = hipLaunchCooperativeKernel((void*)mega_kernel, dim3(grid_blocks), dim3(NTHREADS), args, LDS_BYTES, stream);
  if (e != hipSuccess) fprintf(stderr, "cooperative launch failed: %s (grid %d)\n", hipGetErrorString(e), grid_blocks);
#endif
}
```
